# Optimizing an MI355X kernel written in HIP

```python
import jax, jax.numpy as jnp
from jax import lax
import numpy as np

D_MODEL = 2048
BATCH = 2
SEQ = 4096
DEPTH = 4
DEC_BATCH = 32
DEC_SEQ = 4
PAST_LEN = 16384
PAGE_SIZE = 128

N_META = 16
MIX_DIM = D_MODEL
ATT_DIM = MIX_DIM // 2
CONV_DIM = MIX_DIM - ATT_DIM
HEAD_DIM = 64
N_HEADS = ATT_DIM // HEAD_DIM
N_KV_HEADS = 4
GQA_GROUP = N_HEADS // N_KV_HEADS
KV_DIM = N_KV_HEADS * HEAD_DIM
WINDOW = 128
BLOCK = 128
CONV_WIDTH = 3
PROJ_DIM = ATT_DIM + 2 * KV_DIM + ATT_DIM + 4 * CONV_DIM
DEEPNORM_ALPHA = (2 * DEPTH) ** 0.25
DEEPNORM_BETA = (8 * DEPTH) ** -0.25
LN_EPS = 1e-5
NEG_INF = -1e30

kernel_name = "hymba_swa_sink_gated_conv_deepnorm_step"


def alibi_slopes():
    return 2.0 ** (-8.0 * jnp.arange(1, N_HEADS + 1, dtype=jnp.float32) / N_HEADS)


def layer_norm(x, g, b):
    xf = x.astype(jnp.float32)
    mu = xf.mean(-1, keepdims=True)
    var = jnp.square(xf - mu).mean(-1, keepdims=True)
    y = (xf - mu) * lax.rsqrt(var + LN_EPS) * g.astype(jnp.float32) + b.astype(jnp.float32)
    return y.astype(x.dtype)


def split_projection(x, w_in):
    n, t = x.shape[:2]
    h = jnp.einsum('btd,dp->btp', x, w_in)
    splits = [ATT_DIM, ATT_DIM + KV_DIM, ATT_DIM + 2 * KV_DIM, 2 * ATT_DIM + 2 * KV_DIM,
              2 * ATT_DIM + 2 * KV_DIM + CONV_DIM, 2 * ATT_DIM + 2 * KV_DIM + 2 * CONV_DIM,
              2 * ATT_DIM + 2 * KV_DIM + 3 * CONV_DIM]
    q, k, v, g_att, b_gate, c_gate, h_conv, g_conv = jnp.split(h, splits, axis=-1)
    q = q.reshape(n, t, N_KV_HEADS, GQA_GROUP, HEAD_DIM)
    k = k.reshape(n, t, N_KV_HEADS, HEAD_DIM)
    v = v.reshape(n, t, N_KV_HEADS, HEAD_DIM)
    u = c_gate * h_conv
    return q, k, v, g_att, b_gate, u, g_conv


def sink_attention(q, k, v, dist, mask, sinks):
    scale = HEAD_DIM ** -0.5
    s = jnp.einsum('...qkgd,...skd->...kgqs', q, k, preferred_element_type=jnp.float32) * scale
    slopes = alibi_slopes().reshape(N_KV_HEADS, GQA_GROUP, 1, 1)
    s = jnp.where(mask, s - slopes * dist.astype(jnp.float32), NEG_INF)
    sink = sinks.astype(jnp.float32).reshape(N_KV_HEADS, GQA_GROUP, 1, 1)
    m = jnp.maximum(s.max(-1, keepdims=True), sink)
    p = jnp.exp(s - m)
    denom = p.sum(-1, keepdims=True) + jnp.exp(sink - m)
    p = (p / denom).astype(v.dtype)
    return jnp.einsum('...kgqs,...skd->...qkgd', p, v)


def prompt_window_attention(q, k, v, sinks):
    b, L = q.shape[:2]
    pad = (-L) % BLOCK
    nb = (L + pad) // BLOCK
    qp = jnp.pad(q, ((0, 0), (pad, 0), (0, 0), (0, 0), (0, 0))).reshape(b, nb, BLOCK, N_KV_HEADS, GQA_GROUP, HEAD_DIM)

    def banded(t):
        tb = jnp.pad(t, ((0, 0), (pad, 0), (0, 0), (0, 0))).reshape(b, nb, BLOCK, N_KV_HEADS, HEAD_DIM)
        prev = jnp.pad(tb[:, :-1], ((0, 0), (1, 0), (0, 0), (0, 0), (0, 0)))
        return jnp.concatenate([prev, tb], axis=2)

    kk, vv = banded(k), banded(v)
    i = jnp.arange(BLOCK)[:, None]
    r = jnp.arange(2 * BLOCK)[None, :]
    dist = BLOCK + i - r
    k_pos = (jnp.arange(nb)[:, None, None] - 1) * BLOCK + r[None] - pad
    mask = (dist >= 0) & (dist < WINDOW) & (k_pos >= 0)
    mask = mask[:, None, None]
    o = sink_attention(qp, kk, vv, dist, mask, sinks)
    return o.reshape(b, nb * BLOCK, ATT_DIM)[:, pad:]


def sample_window_attention(q, k_new, v_new, cache_k, cache_v, sinks):
    n, t = q.shape[:2]
    w = cache_k.shape[1]
    kk = jnp.concatenate([cache_k.astype(k_new.dtype), k_new], axis=1)
    vv = jnp.concatenate([cache_v.astype(v_new.dtype), v_new], axis=1)
    i = jnp.arange(t)[:, None]
    r = jnp.arange(w + t)[None, :]
    dist = w + i - r
    mask = (dist >= 0) & (dist < WINDOW)
    o = sink_attention(q, kk, vv, dist, mask, sinks)
    return o.reshape(n, t, ATT_DIM), kk[:, -WINDOW:], vv[:, -WINDOW:]


def causal_conv(u, w, prev):
    t = u.shape[1]
    ext = jnp.concatenate([prev.astype(u.dtype), u], axis=1)
    y = w[0] * ext[:, 0:t]
    for j in range(1, CONV_WIDTH):
        y = y + w[j] * ext[:, j:j + t]
    return y, ext[:, -(CONV_WIDTH - 1):]


def combine(x, o_att, o_conv, g_att, g_conv, w_out, ln_g, ln_b):
    mix = jnp.concatenate([o_att * jax.nn.silu(g_att), o_conv * jax.nn.silu(g_conv)], axis=-1)
    out = jnp.einsum('btm,md->btd', mix, w_out)
    return layer_norm(DEEPNORM_ALPHA * x + out, ln_g, ln_b)


def setup_inputs(seed: int = 0) -> dict:
    key = jax.random.key(seed)
    ks = jax.random.split(key, 12)
    f32 = jnp.float32
    return {
        "x_prompt": jax.random.normal(ks[0], (BATCH, SEQ, D_MODEL), f32),
        "x_sample": jax.random.normal(ks[1], (DEC_BATCH, DEC_SEQ, D_MODEL), f32),
        "cache_k": jax.random.normal(ks[2], (DEPTH, DEC_BATCH, WINDOW, N_KV_HEADS, HEAD_DIM), f32),
        "cache_v": jax.random.normal(ks[3], (DEPTH, DEC_BATCH, WINDOW, N_KV_HEADS, HEAD_DIM), f32),
        "state_conv": jax.random.normal(ks[4], (DEPTH, DEC_BATCH, CONV_WIDTH - 1, CONV_DIM), f32),
        "meta_tokens": jax.random.normal(ks[5], (N_META, D_MODEL), f32),
        "w_in": jax.random.normal(ks[6], (DEPTH, D_MODEL, PROJ_DIM), f32) * D_MODEL ** -0.5,
        "conv_w": jax.random.normal(ks[7], (DEPTH, CONV_WIDTH, CONV_DIM), f32) * CONV_WIDTH ** -0.5,
        "sinks": jax.random.normal(ks[8], (DEPTH, N_HEADS), f32) * 0.5,
        "w_out": jax.random.normal(ks[9], (DEPTH, MIX_DIM, D_MODEL), f32) * (MIX_DIM ** -0.5 * DEEPNORM_BETA),
        "ln_g": 1.0 + 0.02 * jax.random.normal(ks[10], (DEPTH, D_MODEL), f32),
        "ln_b": 0.02 * jax.random.normal(ks[11], (DEPTH, D_MODEL), f32),
    }


def reference(x_prompt, x_sample, cache_k, cache_v, state_conv, meta_tokens,
              w_in, conv_w, sinks, w_out, ln_g, ln_b):
    b = x_prompt.shape[0]
    meta = jnp.broadcast_to(meta_tokens[None].astype(x_prompt.dtype), (b, N_META, D_MODEL))
    xp = jnp.concatenate([meta, x_prompt], axis=1)
    xs = x_sample
    kp_l, vp_l, cp_l, ks_l, vs_l, cs_l = [], [], [], [], [], []
    for l in range(DEPTH):
        q, k, v, g_a, b_g, u, g_c = split_projection(xp, w_in[l])
        o_att = prompt_window_attention(q, k, v, sinks[l])
        cy, c_state = causal_conv(u, conv_w[l], jnp.zeros((b, CONV_WIDTH - 1, CONV_DIM), u.dtype))
        xp = combine(xp, o_att, b_g * cy, g_a, g_c, w_out[l], ln_g[l], ln_b[l])
        kp_l.append(k[:, -WINDOW:])
        vp_l.append(v[:, -WINDOW:])
        cp_l.append(c_state)
        q, k, v, g_a, b_g, u, g_c = split_projection(xs, w_in[l])
        o_att, k_buf, v_buf = sample_window_attention(q, k, v, cache_k[l], cache_v[l], sinks[l])
        cy, c_state = causal_conv(u, conv_w[l], state_conv[l])
        xs = combine(xs, o_att, b_g * cy, g_a, g_c, w_out[l], ln_g[l], ln_b[l])
        ks_l.append(k_buf)
        vs_l.append(v_buf)
        cs_l.append(c_state)
    y_prompt = xp[:, N_META:]
    return (y_prompt, xs, jnp.stack(kp_l), jnp.stack(vp_l), jnp.stack(cp_l),
            jnp.stack(ks_l), jnp.stack(vs_l), jnp.stack(cs_l))
```

```cpp
#include <hip/hip_runtime.h>
#include <hip/hip_bf16.h>
#include <cstdio>
#include <cstdint>
#include <cmath>

#ifndef N_LAUNCHES
#define N_LAUNCHES 1
#endif

constexpr int DMODEL = 2048, NB = 2, SEQ = 4096, DEPTH = 4, DECB = 32, DECSEQ = 4, NMETA = 16;
constexpr int ATT = 1024, CONVD = 1024, HD = 64, NHEADS = 16, NKV = 4, KVDIM = NKV * HD, WINDOW = 128;
constexpr int PROJ = ATT + 2 * KVDIM + ATT + 4 * CONVD;
constexpr int LSEQ = NMETA + SEQ;
constexpr int MP = NB * LSEQ, MS = DECB * DECSEQ, MV = MP + MS;
constexpr int MPAD = 8448;
constexpr int H_Q = 0, H_K = ATT, H_V = ATT + KVDIM, H_GA = ATT + 2 * KVDIM, H_BG = H_GA + ATT, H_CG = H_BG + CONVD, H_HC = H_CG + CONVD, H_GC = H_HC + CONVD;
constexpr float ALPHA = 1.6817928305074290861f;
constexpr int O_YP = 0, O_YS = O_YP + NB * SEQ * DMODEL, O_KWP = O_YS + MS * DMODEL, O_VWP = O_KWP + DEPTH * NB * WINDOW * KVDIM, O_CP = O_VWP + DEPTH * NB * WINDOW * KVDIM,
              O_KWS = O_CP + DEPTH * NB * 2 * CONVD, O_VWS = O_KWS + DEPTH * DECB * WINDOW * KVDIM, O_CS = O_VWS + DEPTH * DECB * WINDOW * KVDIM, O_TOTAL = O_CS + DEPTH * DECB * 2 * CONVD;
static_assert(O_TOTAL == 26230784, "output size");
constexpr size_t MiB = 1u << 20;
constexpr size_t WS_CTL = 0, CTL_ZERO_BYTES = 1 * MiB;
constexpr size_t WS_C1 = 256 * 1024, WS_C2 = 512 * 1024;
constexpr size_t WS_XST = 2 * MiB;
constexpr size_t WS_WTIN = 4 * MiB;
constexpr size_t WS_WTOUT = 108 * MiB;
constexpr size_t WS_Y = 140 * MiB;
constexpr size_t WS_YB = 206 * MiB;
constexpr size_t WS_MIX = 239 * MiB;
constexpr size_t WS_H = 272 * MiB;
constexpr size_t WS_END = 380 * MiB;
static_assert(WS_C1 + (size_t)DEPTH * PROJ * 4 <= WS_C2 && WS_C2 + (size_t)DEPTH * PROJ * 4 <= CTL_ZERO_BYTES, "c1/c2");
static_assert(WS_XST + (size_t)2 * MPAD * 16 * 4 <= WS_WTIN && WS_WTIN + (size_t)DEPTH * PROJ * DMODEL * 2 <= WS_WTOUT && WS_WTOUT + (size_t)DEPTH * DMODEL * DMODEL * 2 <= WS_Y, "ws map 1");
static_assert(WS_Y + (size_t)MPAD * DMODEL * 4 <= WS_YB && WS_YB + (size_t)MPAD * DMODEL * 2 <= WS_MIX && WS_MIX + (size_t)MPAD * DMODEL * 2 <= WS_H && WS_H + (size_t)MPAD * PROJ * 2 <= WS_END, "ws map 2");
constexpr int CW_BAR = 4096;
constexpr int NWAVES = 8;
constexpr int RING_BYTES = 131072;
constexpr int LDSCTL_OFF = RING_BYTES, MISC_OFF = LDSCTL_OFF + 320;
constexpr int XLDS_OFF = RING_BYTES + 1024;
constexpr int LDS_BYTES = 147456;
static_assert(XLDS_OFF + 8192 <= LDS_BYTES, "LDS map");
namespace pg8 {
#define PG8_LAS __attribute__((address_space(3)))
typedef unsigned short bf16_t;
typedef short bf16x8 __attribute__((ext_vector_type(8)));
typedef float f32x4 __attribute__((ext_vector_type(4)));
typedef unsigned u32x4 __attribute__((ext_vector_type(4)));
constexpr int BM = 256, BK = 64, HALF = 128, HTB = HALF * BK * 2  , STAGE_BYTES = 8 * HTB, NXCD = 8, WGM = 8;

__host__ __device__ __forceinline__ int lds_byte(int r, int c) { const int st = (r >> 4) * 2 + (c >> 5), rr = r & 15, cc = c & 31, ob = rr * 64 + cc * 2; return st * 1024 + (ob ^ (((ob >> 9) & 1) << 5)); }
__host__ __device__ __forceinline__ void stage_rc(int b, int& R, int& C) { const int st = b / 1024, sb = b % 1024, swz = sb ^ (((sb >> 9) & 1) << 5); R = (st >> 1) * 16 + swz / 64; C = (st & 1) * 32 + (swz % 64) / 2; }
__host__ __device__ __forceinline__ int perm32(int rho) { const int n = rho >> 4, i = rho & 15; return 8 * (i >> 2) + 4 * n + (i & 3); }

struct Unit { int pm, pn; };
struct Gemm { const bf16_t* A; const bf16_t* Bt; int M, N, K; };

struct StaticOrder {
    int nM, nN, nwg, G, c;
    __host__ __device__ void init(int M, int N, int G_, int c_) { nM = M / BM; nN = N / BM; nwg = nM * nN; G = G_; c = c_; }
    __host__ __device__ bool next(int i, Unit& u) const {
        const long L = (long)i * G + c; if (L >= nwg) return false;
        int wgid = (int)L; { const int q = nwg / NXCD, r = nwg % NXCD, xcd = wgid % NXCD, off = wgid / NXCD; wgid = (xcd < r ? xcd * (q + 1) : r * (q + 1) + (xcd - r) * q) + off; }
        const int nig = WGM * nN, gid = wgid / nig, fm = gid * WGM, gsz = (nM - fm) < WGM ? (nM - fm) : WGM;
        u.pm = fm + ((wgid % nig) % gsz); u.pn = (wgid % nig) / gsz; return true;
    }
    __device__ __forceinline__ void a_ready(const Unit&) const {}
    __device__ __forceinline__ void done(const Unit&) const {}
};


typedef float f32x2t __attribute__((ext_vector_type(2))); typedef __bf16 bf16x2t __attribute__((ext_vector_type(2)));
__device__ __forceinline__ unsigned cvt_pk_bf16(float lo, float hi) { f32x2t v = {lo, hi}; bf16x2t b = __builtin_convertvector(v, bf16x2t); return __builtin_bit_cast(unsigned, b); }
typedef float f32x2v __attribute__((ext_vector_type(2)));
typedef unsigned u32x2v __attribute__((ext_vector_type(2)));
constexpr float LN_EPS_F = 1e-5f;
constexpr int DM = 2048;
__device__ __forceinline__ void row_stats(const float* st, float& mu, float& rstd) {
    const f32x4 a = *(const f32x4*)(st), b = *(const f32x4*)(st + 4), c = *(const f32x4*)(st + 8), d = *(const f32x4*)(st + 12);
    const float mean = (((a[0] + a[2]) + (b[0] + b[2])) + ((c[0] + c[2]) + (d[0] + d[2]))) * 0.125f;
    float q = ((a[1] + a[3]) + (b[1] + b[3])) + ((c[1] + c[3]) + (d[1] + d[3]));
    float e, s;
    e = a[0] - mean; s = e * e; e = a[2] - mean; s += e * e; e = b[0] - mean; s += e * e; e = b[2] - mean; s += e * e;
    e = c[0] - mean; s += e * e; e = c[2] - mean; s += e * e; e = d[0] - mean; s += e * e; e = d[2] - mean; s += e * e;
    q += 256.0f * s;
    mu = mean; rstd = 1.0f / sqrtf(q * (1.0f / (float)DM) + LN_EPS_F);
}
struct EpiH {
    static constexpr bool PERM = true, AFTER_DRAIN = false;
    bf16_t* H; int ldc; const float* c1; const float* c2; const float* stats; int has_ln;
    __device__ __forceinline__ void operator()(f32x4 (&acc)[2][2][4][2], const Unit& u, int wr, int wc, int fr, int fq) const {
        const int row0 = u.pm * BM + wr * 64 + fr, col0 = u.pn * BM + wc * 32 + 8 * fq;
        f32x4 c1v[2][2], c2v[2][2];
#pragma unroll
        for (int bj = 0; bj < 2; ++bj)
#pragma unroll
            for (int n = 0; n < 2; ++n) { c1v[bj][n] = *(const f32x4*)(c1 + col0 + bj * HALF + 4 * n); c2v[bj][n] = *(const f32x4*)(c2 + col0 + bj * HALF + 4 * n);
                if (!has_ln) { c1v[bj][n] = (f32x4){0.f, 0.f, 0.f, 0.f}; c2v[bj][n] = (f32x4){0.f, 0.f, 0.f, 0.f}; } }
#pragma unroll
        for (int ai = 0; ai < 2; ++ai)
#pragma unroll
            for (int m = 0; m < 4; ++m) { const int row = row0 + ai * HALF + m * 16; float mu, rs;
                row_stats(stats + (size_t)row * 16, mu, rs); if (!has_ln) { mu = 0.f; rs = 1.f; } asm volatile("" : "+v"(mu), "+v"(rs) :: "memory");
                bf16_t* rowp = H + (size_t)row * ldc + col0;
#pragma unroll
                for (int bj = 0; bj < 2; ++bj) { const f32x4 v0 = (acc[ai][bj][m][0] - mu * c1v[bj][0]) * rs + c2v[bj][0], v1 = (acc[ai][bj][m][1] - mu * c1v[bj][1]) * rs + c2v[bj][1];
                    u32x4 w; w.x = cvt_pk_bf16(v0[0], v0[1]); w.y = cvt_pk_bf16(v0[2], v0[3]); w.z = cvt_pk_bf16(v1[0], v1[1]); w.w = cvt_pk_bf16(v1[2], v1[3]);
                    *(u32x4*)(rowp + bj * HALF) = w; }
                if (m & 1) asm volatile("" ::: "memory"); }
    }
};
struct EpiY {
    static constexpr bool PERM = false, AFTER_DRAIN = false;
    float* Y; bf16_t* Yb; const float* stats_prev; float* stats_out; const float* g; const float* b; int has_ln; float alpha; PG8_LAS unsigned char* xlds;
    __device__ __forceinline__ void operator()(f32x4 (&acc)[2][2][4][2], const Unit& u, int wr, int wc, int fr, int fq) const {
        const int col0 = u.pn * BM + wc * 32 + 4 * fq;
        float mu[2][4], rs[2][4];
#pragma unroll
        for (int ai = 0; ai < 2; ++ai)
#pragma unroll
            for (int m = 0; m < 4; ++m) { float a_, b_; row_stats(stats_prev + (size_t)(u.pm * BM + ai * HALF + wr * 64 + m * 16 + fr) * 16, a_, b_);
                mu[ai][m] = has_ln ? a_ : 0.f; rs[ai][m] = has_ln ? b_ : 1.f; asm volatile("" : "+v"(mu[ai][m]), "+v"(rs[ai][m]) :: "memory"); }
        const float* ybase = Y + (size_t)(u.pm * BM + wr * 64 + fr) * DM + col0;
#pragma unroll
        for (int bj = 0; bj < 2; ++bj)
#pragma unroll
            for (int n = 0; n < 2; ++n) { f32x4 gv = *(const f32x4*)(g + col0 + bj * HALF + n * 16), bv = *(const f32x4*)(b + col0 + bj * HALF + n * 16);
                if (!has_ln) { gv = (f32x4){1.f, 1.f, 1.f, 1.f}; bv = (f32x4){0.f, 0.f, 0.f, 0.f}; }
#pragma unroll
                for (int ai = 0; ai < 2; ++ai) {
#pragma unroll
                    for (int m = 0; m < 4; ++m) { const f32x4 yp = *(const f32x4*)(ybase + (size_t)(ai * HALF + m * 16) * DM + bj * HALF + n * 16);
                        const f32x4 x = (yp - mu[ai][m]) * rs[ai][m] * gv + bv; acc[ai][bj][m][n] = x * alpha + acc[ai][bj][m][n]; }
                    asm volatile("" : "+v"(acc[ai][bj][0][n]), "+v"(acc[ai][bj][1][n]), "+v"(acc[ai][bj][2][n]), "+v"(acc[ai][bj][3][n]) :: "memory"); } }
        PG8_LAS f32x2v* P = (PG8_LAS f32x2v*)xlds;
#pragma unroll
        for (int ai = 0; ai < 2; ++ai)
#pragma unroll
            for (int m = 0; m < 4; ++m) {
                float s = 0.f;
#pragma unroll
                for (int bj = 0; bj < 2; ++bj)
#pragma unroll
                    for (int n = 0; n < 2; ++n) { const f32x4 x = acc[ai][bj][m][n]; s += (x[0] + x[1]) + (x[2] + x[3]); }
                s += __shfl_xor(s, 16); s += __shfl_xor(s, 32);
                const float mw = s * (1.0f / 64.0f); float q = 0.f;
#pragma unroll
                for (int bj = 0; bj < 2; ++bj)
#pragma unroll
                    for (int n = 0; n < 2; ++n) { const f32x4 d = acc[ai][bj][m][n] - mw; q += (d[0] * d[0] + d[1] * d[1]) + (d[2] * d[2] + d[3] * d[3]); }
                q += __shfl_xor(q, 16); q += __shfl_xor(q, 32);
                if (fq == 0) P[(ai * HALF + wr * 64 + m * 16 + fr) * 4 + wc] = (f32x2v){mw, q};
            }
        asm volatile("s_waitcnt lgkmcnt(0)" ::: "memory"); __builtin_amdgcn_s_barrier(); asm volatile("" ::: "memory");
        { const int wid = wr * 4 + wc, lane = fq * 16 + fr, row = wid * 32 + (lane & 31);
          if (lane < 32) {
            const f32x2v a = P[row * 4 + 0], b2 = P[row * 4 + 1], c = P[row * 4 + 2], d = P[row * 4 + 3];
            const float mt = ((a.x + b2.x) + (c.x + d.x)) * 0.25f;
            const float da = a.x - mt, db = b2.x - mt, dc = c.x - mt, dd = d.x - mt;
            const float m2 = ((a.y + b2.y) + (c.y + d.y)) + 64.0f * ((da * da + db * db) + (dc * dc + dd * dd));
            *(f32x2v*)(stats_out + ((size_t)(u.pm * BM + row) * 8 + u.pn) * 2) = (f32x2v){mt, m2};
          } }
#pragma unroll
        for (int ai = 0; ai < 2; ++ai)
#pragma unroll
            for (int m = 0; m < 4; ++m) { const size_t off = (size_t)(u.pm * BM + ai * HALF + wr * 64 + m * 16 + fr) * DM + col0;
#pragma unroll
                for (int bj = 0; bj < 2; ++bj)
#pragma unroll
                    for (int n = 0; n < 2; ++n) { const f32x4 y = acc[ai][bj][m][n]; *(f32x4*)(Y + off + bj * HALF + n * 16) = y;
                        u32x2v w; w.x = cvt_pk_bf16(y[0], y[1]); w.y = cvt_pk_bf16(y[2], y[3]); *(u32x2v*)(Yb + off + bj * HALF + n * 16) = w; } }
    }
};
template <class Epi, class Sched, bool ALIGN_EPI = false, bool SP2 = false>
__device__ __forceinline__ void gemm_phase(PG8_LAS unsigned char* lds, const Gemm g, const Sched& S, const Epi& E) {
    int tid = threadIdx.x; asm volatile("" : "+v"(tid));
    const int wid = __builtin_amdgcn_readfirstlane(tid >> 6), lane = tid & 63, wr = wid >> 2, wc = wid & 3, fr = lane & 15, fq = lane >> 4;
    const int K = g.K, nt = K / BK;
    unsigned voffA[2], voffB[2];
#pragma unroll
    for (int i = 0; i < 2; ++i) { int R, C; stage_rc(tid * 16 + i * 8192, R, C); const int Rb = Epi::PERM ? ((R & ~31) + perm32(R & 31)) : R;
        voffA[i] = (unsigned)(R * K + C) * 2u; voffB[i] = (unsigned)(Rb * K + C) * 2u; }
    const size_t kstep = (size_t)(BK * 2);
    const size_t hstep = (size_t)HALF * K * 2;
    const size_t tstep = 2 * hstep;
    const unsigned ldsw = (unsigned)wid * 1024u;
    const int aoff = lds_byte(wr * 64 + fr, fq * 8), boff = lds_byte(wc * 32 + fr, fq * 8);
#define PG8_SA(b, h) (((b) * 2 + (h)) * HTB)
#define PG8_SB(b, h) ((4 + (b) * 2 + (h)) * HTB)
#define PG8_STAGE(bufoff, gbase, voff) do { _Pragma("unroll") for (int _i = 0; _i < 2; ++_i) \
        __builtin_amdgcn_global_load_lds((const unsigned*)((const char*)(gbase) + (voff)[_i]), (PG8_LAS unsigned*)(lds + (bufoff) + ldsw + _i * 8192), 16, 0, 0); } while (0)
#define PG8_LDA(dst, b, h) do { _Pragma("unroll") for (int m = 0; m < 4; ++m) _Pragma("unroll") for (int k = 0; k < 2; ++k) dst[m][k] = *(const PG8_LAS bf16x8*)(lds + PG8_SA(b, h) + aoff + m * 2048 + k * 1024); } while (0)
#define PG8_LDB(dst, b, h) do { _Pragma("unroll") for (int n = 0; n < 2; ++n) _Pragma("unroll") for (int k = 0; k < 2; ++k) dst[n][k] = *(const PG8_LAS bf16x8*)(lds + PG8_SB(b, h) + boff + n * 2048 + k * 1024); } while (0)
#define PG8_MMA(ai, bj, At, Bt) do { __builtin_amdgcn_s_setprio(1); _Pragma("unroll") for (int m = 0; m < 4; ++m) _Pragma("unroll") for (int n = 0; n < 2; ++n) _Pragma("unroll") for (int k = 0; k < 2; ++k) \
        acc[ai][bj][m][n] = __builtin_amdgcn_mfma_f32_16x16x32_bf16(Bt[n][k], At[m][k], acc[ai][bj][m][n], 0, 0, 0); __builtin_amdgcn_s_setprio(0); } while (0)
#define PG8_WAIT_V(n) asm volatile("s_waitcnt vmcnt(" #n ")" ::: "memory")
#define PG8_WAIT_L(n) asm volatile("s_waitcnt lgkmcnt(" #n ")" ::: "memory")
#define PG8_BAR __builtin_amdgcn_s_barrier()
#define PG8_SCHED __builtin_amdgcn_sched_barrier(0)
    Unit cur, nxt; int ui = 0;
    if (!S.next(0, cur)) return;
    f32x4 acc[2][2][4][2];
#pragma unroll
    for (int a = 0; a < 2; ++a)
#pragma unroll
        for (int b = 0; b < 2; ++b)
#pragma unroll
            for (int m = 0; m < 4; ++m)
#pragma unroll
                for (int n = 0; n < 2; ++n) acc[a][b][m][n] = (f32x4){0.f, 0.f, 0.f, 0.f};
    bf16x8 At[4][2], B0[2][2], B1[2][2];
    const char* cA = (const char*)g.A + (size_t)cur.pm * tstep; const char* cB = (const char*)g.Bt + (size_t)cur.pn * tstep;
    S.a_ready(cur);
    if constexpr (SP2) {
        PG8_STAGE(PG8_SB(0, 0), cB, voffB); PG8_STAGE(PG8_SB(0, 1), cB + hstep, voffB); PG8_STAGE(PG8_SA(0, 0), cA, voffA); PG8_STAGE(PG8_SA(0, 1), cA + hstep, voffA);
        if (wr == 1) PG8_BAR;
        PG8_WAIT_V(2); PG8_BAR;
        PG8_STAGE(PG8_SB(1, 0), cB + kstep, voffB); PG8_STAGE(PG8_SA(1, 0), cA + kstep, voffA); PG8_STAGE(PG8_SB(1, 1), cB + hstep + kstep, voffB);
        PG8_WAIT_V(6); PG8_BAR;
    } else {
        PG8_STAGE(PG8_SB(0, 0), cB, voffB); PG8_STAGE(PG8_SA(0, 0), cA, voffA); PG8_STAGE(PG8_SB(0, 1), cB + hstep, voffB); PG8_STAGE(PG8_SA(0, 1), cA + hstep, voffA);
        if (wr == 1) PG8_BAR;
        PG8_WAIT_V(4); PG8_BAR;
        PG8_STAGE(PG8_SB(1, 0), cB + kstep, voffB); PG8_STAGE(PG8_SA(1, 0), cA + kstep, voffA); PG8_STAGE(PG8_SB(1, 1), cB + hstep + kstep, voffB);
        PG8_WAIT_V(6); PG8_BAR;
    }
    for (;;) {
        const bool has_next = S.next(ui + 1, nxt);
        const char* nA = has_next ? (const char*)g.A + (size_t)nxt.pm * tstep : cA; const char* nB = has_next ? (const char*)g.Bt + (size_t)nxt.pn * tstep : cB;
        for (int t = 0; t < nt; t += 2) {
            const bool last = (t == nt - 2);
            const char* a1 = cA + (size_t)(t + 1) * kstep;
            const char* a2 = last ? nA : cA + (size_t)(t + 2) * kstep; const char* b2 = last ? nB : cB + (size_t)(t + 2) * kstep;
            const char* a3 = a2 + kstep; const char* b3 = b2 + kstep;
            if (last && has_next) S.a_ready(nxt);
            if constexpr (SP2) {
            PG8_LDB(B0, 0, 0); PG8_LDB(B1, 0, 1); PG8_SCHED; PG8_LDA(At, 0, 0); PG8_STAGE(PG8_SA(1, 1), a1 + hstep, voffA);
            PG8_WAIT_V(8); PG8_WAIT_L(0); PG8_BAR; PG8_MMA(0, 0, At, B0); PG8_MMA(0, 1, At, B1); PG8_BAR; PG8_SCHED;
            PG8_LDA(At, 0, 1); PG8_STAGE(PG8_SB(0, 0), b2, voffB); PG8_STAGE(PG8_SB(0, 1), b2 + hstep, voffB); PG8_STAGE(PG8_SA(0, 0), a2, voffA);
            PG8_WAIT_V(8); PG8_WAIT_L(0); PG8_BAR; PG8_MMA(1, 0, At, B0); PG8_MMA(1, 1, At, B1); PG8_BAR; PG8_SCHED;
            PG8_LDB(B0, 1, 0); PG8_LDB(B1, 1, 1); PG8_SCHED; PG8_LDA(At, 1, 0); PG8_STAGE(PG8_SA(0, 1), a2 + hstep, voffA);
            PG8_WAIT_V(8); PG8_WAIT_L(0); PG8_BAR; PG8_MMA(0, 0, At, B0); PG8_MMA(0, 1, At, B1); PG8_BAR; PG8_SCHED;
            PG8_LDA(At, 1, 1); PG8_STAGE(PG8_SB(1, 0), b3, voffB); PG8_STAGE(PG8_SB(1, 1), b3 + hstep, voffB); PG8_STAGE(PG8_SA(1, 0), a3, voffA);
            PG8_WAIT_V(8); PG8_WAIT_L(0); PG8_BAR; PG8_MMA(1, 0, At, B0); PG8_MMA(1, 1, At, B1); PG8_BAR; PG8_SCHED;
            } else {
            PG8_LDB(B0, 0, 0); PG8_SCHED; PG8_LDA(At, 0, 0); PG8_STAGE(PG8_SA(1, 1), a1 + hstep, voffA);
            PG8_WAIT_L(8); PG8_BAR; PG8_WAIT_L(0); PG8_MMA(0, 0, At, B0); PG8_BAR; PG8_SCHED;
            PG8_LDB(B1, 0, 1); PG8_STAGE(PG8_SB(0, 0), b2, voffB);
            PG8_BAR; PG8_WAIT_L(0); PG8_MMA(0, 1, At, B1); PG8_BAR;
            PG8_LDA(At, 0, 1); PG8_STAGE(PG8_SA(0, 0), a2, voffA);
            PG8_BAR; PG8_WAIT_L(0); PG8_MMA(1, 0, At, B0); PG8_BAR; PG8_SCHED;
            PG8_STAGE(PG8_SB(0, 1), b2 + hstep, voffB);
            PG8_WAIT_V(6); PG8_BAR; PG8_MMA(1, 1, At, B1); PG8_BAR;
            PG8_LDB(B0, 1, 0); PG8_SCHED; PG8_LDA(At, 1, 0); PG8_STAGE(PG8_SA(0, 1), a2 + hstep, voffA);
            PG8_WAIT_L(8); PG8_BAR; PG8_WAIT_L(0); PG8_MMA(0, 0, At, B0); PG8_BAR; PG8_SCHED;
            PG8_LDB(B1, 1, 1); PG8_STAGE(PG8_SB(1, 0), b3, voffB);
            PG8_BAR; PG8_WAIT_L(0); PG8_MMA(0, 1, At, B1); PG8_BAR;
            PG8_LDA(At, 1, 1); PG8_STAGE(PG8_SA(1, 0), a3, voffA);
            PG8_BAR; PG8_WAIT_L(0); PG8_MMA(1, 0, At, B0); PG8_BAR; PG8_SCHED;
            PG8_STAGE(PG8_SB(1, 1), b3 + hstep, voffB);
            PG8_WAIT_V(6); PG8_BAR; PG8_MMA(1, 1, At, B1); PG8_BAR;
            }
        }
        if constexpr (ALIGN_EPI) { if (wr == 0) PG8_BAR; }
        if constexpr (!Epi::AFTER_DRAIN) { E(acc, cur, wr, wc, fr, fq); S.done(cur); }
        if (!has_next) break;
#pragma unroll
        for (int a = 0; a < 2; ++a)
#pragma unroll
            for (int b = 0; b < 2; ++b)
#pragma unroll
                for (int m = 0; m < 4; ++m)
#pragma unroll
                    for (int n = 0; n < 2; ++n) acc[a][b][m][n] = (f32x4){0.f, 0.f, 0.f, 0.f};
        cur = nxt; cA = nA; cB = nB; ++ui;
        if constexpr (ALIGN_EPI) { if (wr == 1) PG8_BAR; }
    }
    PG8_WAIT_V(0);
    if constexpr (!ALIGN_EPI) { if (wr == 0) PG8_BAR; }
    PG8_BAR;
    if constexpr (Epi::AFTER_DRAIN) { E.fused(acc, cur, wr, wc, fr, fq, lds, wid, lane); S.done(cur); }
#undef PG8_SA
#undef PG8_SB
#undef PG8_STAGE
#undef PG8_LDA
#undef PG8_LDB
#undef PG8_MMA
#undef PG8_WAIT_V
#undef PG8_WAIT_L
#undef PG8_BAR
#undef PG8_SCHED
}
}
#define GAS __attribute__((address_space(1)))
#define LAS __attribute__((address_space(3)))
typedef unsigned short bf16;
typedef unsigned v4u __attribute__((ext_vector_type(4)));
typedef float f32x4 __attribute__((ext_vector_type(4)));
typedef short bf16x8 __attribute__((ext_vector_type(8)));
typedef GAS unsigned gu32;
typedef GAS unsigned long long gu64;
#define RLX_AGENT __ATOMIC_RELAXED, __HIP_MEMORY_SCOPE_AGENT
#define LDS_WAIT() asm volatile("s_waitcnt lgkmcnt(0)" ::: "memory")
#define VM_WAIT() asm volatile("s_waitcnt vmcnt(0)" ::: "memory")
__device__ __forceinline__ unsigned long long rt() { return __builtin_amdgcn_s_memrealtime(); }
__device__ __forceinline__ unsigned f2bf(float f) { unsigned u = __builtin_bit_cast(unsigned, f); return (u + 0x7fffu + ((u >> 16) & 1u)) >> 16; }
__device__ __forceinline__ unsigned pk2(float lo, float hi) { return f2bf(lo) | (f2bf(hi) << 16); }

#define XB_TMO      128
#define XB_XCNT(j)  (256  + 64 * (j))
#define XB_XSUB(j)  (1280 + 64 * (j))
#define XB_XGEN(j)  (2304 + 64 * (j))
#define XB_TOP      3328
#define XB_TOPGEN   3392
#define XCD_BAR_WORDS 3456
#define XB_SPIN_CAP (1u << 18)

__device__ __forceinline__ unsigned xb_ld(unsigned* p)              { return __hip_atomic_load(p, __ATOMIC_RELAXED, __HIP_MEMORY_SCOPE_AGENT); }
__device__ __forceinline__ unsigned xb_add(unsigned* p, unsigned v) { return __hip_atomic_fetch_add(p, v, __ATOMIC_RELAXED, __HIP_MEMORY_SCOPE_AGENT); }
__device__ __forceinline__ unsigned xb_xcc_id() { return (unsigned)__builtin_amdgcn_s_getreg((3 << 11) | 20) & 0xFu; }
#define XB_SPIN(cond, bar) do { unsigned _sp = 0; while (cond) { __builtin_amdgcn_s_sleep(1); \
    if ((++_sp & 255u) == 0u) { if (xb_ld(&(bar)[XB_TMO])) break; if (_sp > XB_SPIN_CAP) { atomicAdd(&(bar)[XB_TMO], 1u); break; } } } } while (0)

struct XcdBarrier {
    unsigned* bar; unsigned x;
    volatile LAS unsigned* st;
};

__device__ __forceinline__ XcdBarrier xcd_barrier_post(unsigned* bar, volatile LAS unsigned* st) {
    XcdBarrier b; b.bar = bar; b.x = xb_xcc_id(); b.st = st;
    if (threadIdx.x == 0) (void)xb_add(&bar[XB_XCNT(b.x)], 1u);
    return b;
}
__device__ __forceinline__ void xcd_barrier_complete(unsigned* bar, unsigned x, unsigned& nloc, unsigned& nx) {
    const unsigned G = gridDim.x * gridDim.y * gridDim.z;
    unsigned sum, cnt, mine, sp = 0u;
    for (;;) {
        sum = 0u; cnt = 0u; mine = 0u;
#pragma unroll
        for (unsigned j = 0; j < 16; ++j) { const unsigned c = xb_ld(&bar[XB_XCNT(j)]); sum += c; cnt += (c > 0u) ? 1u : 0u; mine = (j == x) ? c : mine; }
        if (sum == G) break;
        __builtin_amdgcn_s_sleep(1);
        if ((++sp & 255u) == 0u) { if (xb_ld(&bar[XB_TMO])) break; if (sp > XB_SPIN_CAP) { atomicAdd(&bar[XB_TMO], 1u); break; } }
    }
    nloc = mine > 0u ? mine : 1u; nx = cnt > 0u ? cnt : 1u;
}

__device__ __forceinline__ void xcd_barrier(const XcdBarrier& b) {
    asm volatile("s_waitcnt vmcnt(0)" ::: "memory");
    __syncthreads();
    if (threadIdx.x == 0) {
        unsigned* bar = b.bar;
        __builtin_amdgcn_s_waitcnt(0);
        unsigned nloc = b.st[0], nx = b.st[1];
        if (nloc == 0u) { xcd_barrier_complete(bar, b.x, nloc, nx); b.st[0] = nloc; b.st[1] = nx; }
        const unsigned old = xb_add(&bar[XB_XSUB(b.x)], 1u);
        const unsigned gen = old / nloc;
        if (old + 1u == (gen + 1u) * nloc) {
            __builtin_amdgcn_fence(__ATOMIC_RELEASE, "agent");
            asm volatile("s_waitcnt vmcnt(0)" ::: "memory");
            const unsigned og = xb_add(&bar[XB_TOP], 1u);
            const unsigned tg = og / nx;
            if (og + 1u == (tg + 1u) * nx) xb_add(&bar[XB_TOPGEN], 1u);
            else XB_SPIN(xb_ld(&bar[XB_TOPGEN]) == tg, bar);
            __builtin_amdgcn_fence(__ATOMIC_ACQUIRE, "agent");
            xb_add(&bar[XB_XGEN(b.x)], 1u);
            asm volatile("s_waitcnt vmcnt(0)" ::: "memory");
        } else {
            XB_SPIN(xb_ld(&bar[XB_XGEN(b.x)]) == gen, bar);
            __builtin_amdgcn_fence(__ATOMIC_ACQUIRE, "agent");
            asm volatile("s_waitcnt vmcnt(0)" ::: "memory");
        }
    }
    __syncthreads();
}


struct Frame {
    LAS unsigned char* lds;
    volatile LAS unsigned* MISC;
    gu32* ctl;
    int tid, lane, wave, G;
    const float *x_prompt, *x_sample, *cache_k, *cache_v, *state_conv, *meta, *w_in, *conv_w, *sinks, *w_out, *ln_g, *ln_b;
    float* out;
    bf16 *WtIn, *WtOut, *Yb, *H, *MIX;
    float *Y, *XST, *C1, *C2;
};

__device__ __forceinline__ float bf_lo(unsigned w) { return __uint_as_float(w << 16); }
__device__ __forceinline__ float bf_hi(unsigned w) { return __uint_as_float(w & 0xffff0000u); }
__device__ __forceinline__ float silu_f(float g) { return g * __builtin_amdgcn_rcpf(1.0f + __builtin_amdgcn_exp2f(-1.4426950408889634f * g)); }
__device__ __forceinline__ float wave_sum(float v) {
#pragma unroll
    for (int o = 1; o < 64; o <<= 1) v += __shfl_xor(v, o);
    return v;
}

__device__ __forceinline__ void p0_transpose_item(const float* W, int K, int N, bf16* WT, const float* gs, const float* bs, float* c1, float* c2, LAS float* scr, int item, int lane) {
    const int nblk = N / 32, kb = item / nblk, nb = item % nblk, k0 = 64 * kb, n0 = 32 * nb;
    float s1 = 0.f, s2 = 0.f;
#pragma unroll 8
    for (int i = 0; i < 32; ++i) { const int kk = 2 * i + (lane >> 5); float w = W[(size_t)(k0 + kk) * N + n0 + (lane & 31)];
        if (gs) { const float wb = w * bs[k0 + kk]; w *= gs[k0 + kk]; s2 += wb; s1 += __uint_as_float(f2bf(w) << 16); }
        scr[kk * 33 + (lane & 31)] = w; }
    if (gs) { s1 += __shfl_xor(s1, 32); s2 += __shfl_xor(s2, 32); if (lane < 32) { atomicAdd(c1 + n0 + lane, s1); atomicAdd(c2 + n0 + lane, s2); } }
    LDS_WAIT(); asm volatile("" ::: "memory");
    const int c = lane & 7;
#pragma unroll
    for (int j = 0; j < 4; ++j) { const int n = (lane >> 3) + 8 * j; const LAS float* s = scr + (8 * c) * 33 + n;
        v4u o; o.x = pk2(s[0 * 33], s[1 * 33]); o.y = pk2(s[2 * 33], s[3 * 33]); o.z = pk2(s[4 * 33], s[5 * 33]); o.w = pk2(s[6 * 33], s[7 * 33]);
        *(GAS v4u*)(WT + (size_t)(n0 + n) * K + k0 + 8 * c) = o; }
    LDS_WAIT(); asm volatile("" ::: "memory");
}
__device__ __forceinline__ void p0_prologue(Frame& F) {
    LAS float* scr = (LAS float*)(F.lds + F.wave * 16384);
    const int gw = blockIdx.x * NWAVES + F.wave, NGW = F.G * NWAVES, lane = F.lane;
    constexpr int I_IN = (DMODEL / 64) * (PROJ / 32), I_OUT = (DMODEL / 64) * (DMODEL / 32);
    constexpr int NITEMS = DEPTH * (I_IN + I_OUT);
    for (int m = gw; m < MPAD; m += NGW) {
        const float* src = nullptr;
        if (m < MP) { const int b = m / LSEQ, pos = m - b * LSEQ; src = pos < NMETA ? F.meta + (size_t)pos * DMODEL : F.x_prompt + ((size_t)b * SEQ + (pos - NMETA)) * DMODEL; }
        else if (m < MV) src = F.x_sample + (size_t)(m - MP) * DMODEL;
        GAS f32x4* yo = (GAS f32x4*)(F.Y + (size_t)m * DMODEL) + lane; GAS unsigned long long* yb = (GAS unsigned long long*)(F.Yb + (size_t)m * DMODEL) + lane;
#pragma unroll
        for (int j = 0; j < 8; ++j) { f32x4 v = (f32x4){0.f, 0.f, 0.f, 0.f}; if (src) v = ((const GAS f32x4*)src)[lane + 64 * j];
            yo[64 * j] = v; yb[64 * j] = (unsigned long long)pk2(v.x, v.y) | ((unsigned long long)pk2(v.z, v.w) << 32); }
    }
    for (int it = gw; it < NITEMS; it += NGW) {
        int r = it; const int l = r / (I_IN + I_OUT); r -= l * (I_IN + I_OUT);
        if (r < I_IN) p0_transpose_item(F.w_in + (size_t)l * DMODEL * PROJ, DMODEL, PROJ, F.WtIn + (size_t)l * PROJ * DMODEL, l > 0 ? F.ln_g + (l - 1) * DMODEL : nullptr, l > 0 ? F.ln_b + (l - 1) * DMODEL : nullptr,
                                         F.C1 + l * PROJ, F.C2 + l * PROJ, scr, r, lane);
        else p0_transpose_item(F.w_out + (size_t)l * DMODEL * DMODEL, DMODEL, DMODEL, F.WtOut + (size_t)l * DMODEL * DMODEL, nullptr, nullptr, nullptr, nullptr, scr, r - I_IN, lane);
    }
    const int gt = blockIdx.x * (NWAVES * 64) + F.tid, NGT = F.G * NWAVES * 64;
    { constexpr int PER = (WINDOW - DECSEQ) * KVDIM / 4;
      for (int e = gt; e < 2 * DEPTH * DECB * PER; e += NGT) { const int which = e / (DEPTH * DECB * PER), r = e - which * (DEPTH * DECB * PER), ln = r / PER, i = r - ln * PER;
          const float* src = (which ? F.cache_v : F.cache_k) + (size_t)ln * WINDOW * KVDIM + DECSEQ * KVDIM; float* dst = F.out + (which ? O_VWS : O_KWS) + (size_t)ln * WINDOW * KVDIM;
          ((GAS f32x4*)dst)[i] = ((const GAS f32x4*)src)[i]; } }
    for (int e = gt; e < (MPAD - MV) * DMODEL / 8; e += NGT) ((GAS v4u*)(F.MIX + (size_t)MV * DMODEL))[e] = (v4u){0u, 0u, 0u, 0u};
}

typedef float f32x16 __attribute__((ext_vector_type(16)));
typedef short s16x4 __attribute__((ext_vector_type(4)));
constexpr int TROW = 144;
constexpr int KT_OFF = 0, VT_OFF = 192 * TROW, ST_OFF = 2 * 192 * TROW, ST_WAVE = 32 * TROW;
static_assert(ST_OFF + NWAVES * ST_WAVE <= 131072, "attention LDS");
__device__ __forceinline__ int crow(int r, int hi) { return (r & 3) + 8 * (r >> 2) + 4 * hi; }
__device__ __forceinline__ s16x4 vtr(const LAS unsigned char* p) { return __builtin_bit_cast(s16x4, __builtin_amdgcn_ds_read_tr16_b64_v4i16((LAS s16x4*)p)); }
__device__ __forceinline__ v4u pack8(f32x4 a, f32x4 b) { v4u o; o.x = pg8::cvt_pk_bf16(a.x, a.y); o.y = pg8::cvt_pk_bf16(a.z, a.w); o.z = pg8::cvt_pk_bf16(b.x, b.y); o.w = pg8::cvt_pk_bf16(b.z, b.w); return o; }

constexpr int NQB = (LSEQ + 63) / 64;
constexpr int N_PUNITS = NB * NKV * NQB, N_SUNITS = DECB * NKV, N_UNITS = N_PUNITS + N_SUNITS;

__device__ __forceinline__ void attn_conv_unit(Frame& F, int layer, int u) {
    const int tid = F.tid, lane = F.lane, wave = F.wave;
    const bf16* H = F.H; bf16* MIX = F.MIX;
    LAS unsigned char* Kt = F.lds + KT_OFF; LAS unsigned char* Vt = F.lds + VT_OFF;
    const bool is_prompt = u < N_PUNITS;
    int kvh, q0 = 0, rowbase, bn;
    if (is_prompt) { const int qb = u % NQB; kvh = (u / NQB) % NKV; bn = u / (NQB * NKV); q0 = qb * 64; rowbase = bn * LSEQ; }
    else { const int us = u - N_PUNITS; bn = us / NKV; kvh = us % NKV; rowbase = MP + bn * DECSEQ; }
    const float* cw = F.conv_w + (size_t)layer * 3 * CONVD;
    {
        const int cg = tid & 31, ch0 = kvh * 256 + cg * 8;
        f32x4 w0a = *(const f32x4*)(cw + ch0), w0b = *(const f32x4*)(cw + ch0 + 4), w1a = *(const f32x4*)(cw + CONVD + ch0), w1b = *(const f32x4*)(cw + CONVD + ch0 + 4),
              w2a = *(const f32x4*)(cw + 2 * CONVD + ch0), w2b = *(const f32x4*)(cw + 2 * CONVD + ch0 + 4);
        if (is_prompt) {
            const int p0 = q0 + 4 * (tid >> 5);
            f32x4 ua[6], ub[6];
#pragma unroll
            for (int i = 0; i < 6; ++i) { const int p = p0 - 2 + i; ua[i] = (f32x4){0.f, 0.f, 0.f, 0.f}; ub[i] = ua[i];
                if (p >= 0 && p < LSEQ) { const bf16* hr = H + (size_t)(rowbase + p) * PROJ; const v4u c = *(const GAS v4u*)(hr + H_CG + ch0), h = *(const GAS v4u*)(hr + H_HC + ch0);
                    ua[i] = (f32x4){bf_lo(c.x) * bf_lo(h.x), bf_hi(c.x) * bf_hi(h.x), bf_lo(c.y) * bf_lo(h.y), bf_hi(c.y) * bf_hi(h.y)};
                    ub[i] = (f32x4){bf_lo(c.z) * bf_lo(h.z), bf_hi(c.z) * bf_hi(h.z), bf_lo(c.w) * bf_lo(h.w), bf_hi(c.w) * bf_hi(h.w)}; } }
#pragma unroll
            for (int i = 0; i < 4; ++i) { const int p = p0 + i;
                if (p < LSEQ) { const bf16* hr = H + (size_t)(rowbase + p) * PROJ; const v4u bg = *(const GAS v4u*)(hr + H_BG + ch0), gc = *(const GAS v4u*)(hr + H_GC + ch0);
                    const f32x4 ya = w0a * ua[i] + w1a * ua[i + 1] + w2a * ua[i + 2], yb = w0b * ub[i] + w1b * ub[i + 1] + w2b * ub[i + 2];
                    f32x4 oa, ob;
                    oa.x = bf_lo(bg.x) * ya.x * silu_f(bf_lo(gc.x)); oa.y = bf_hi(bg.x) * ya.y * silu_f(bf_hi(gc.x)); oa.z = bf_lo(bg.y) * ya.z * silu_f(bf_lo(gc.y)); oa.w = bf_hi(bg.y) * ya.w * silu_f(bf_hi(gc.y));
                    ob.x = bf_lo(bg.z) * yb.x * silu_f(bf_lo(gc.z)); ob.y = bf_hi(bg.z) * yb.y * silu_f(bf_hi(gc.z)); ob.z = bf_lo(bg.w) * yb.z * silu_f(bf_lo(gc.w)); ob.w = bf_hi(bg.w) * yb.w * silu_f(bf_hi(gc.w));
                    *(GAS v4u*)(MIX + (size_t)(rowbase + p) * DMODEL + ATT + ch0) = pack8(oa, ob);
                    if (p >= LSEQ - 2) { float* cs = F.out + O_CP + ((size_t)(layer * NB + bn) * 2 + (p - (LSEQ - 2))) * CONVD + ch0; *(GAS f32x4*)cs = ua[i + 2]; *(GAS f32x4*)(cs + 4) = ub[i + 2]; } } }
        } else if (tid < 128) {
            const int t = tid >> 5;
            f32x4 ua[3], ub[3];
#pragma unroll
            for (int i = 0; i < 3; ++i) { const int p = t - 2 + i;
                if (p >= 0) { const bf16* hr = H + (size_t)(rowbase + p) * PROJ; const v4u c = *(const GAS v4u*)(hr + H_CG + ch0), h = *(const GAS v4u*)(hr + H_HC + ch0);
                    ua[i] = (f32x4){bf_lo(c.x) * bf_lo(h.x), bf_hi(c.x) * bf_hi(h.x), bf_lo(c.y) * bf_lo(h.y), bf_hi(c.y) * bf_hi(h.y)};
                    ub[i] = (f32x4){bf_lo(c.z) * bf_lo(h.z), bf_hi(c.z) * bf_hi(h.z), bf_lo(c.w) * bf_lo(h.w), bf_hi(c.w) * bf_hi(h.w)}; }
                else { const float* sr = F.state_conv + ((size_t)(layer * DECB + bn) * 2 + (2 + p)) * CONVD + ch0; ua[i] = *(const GAS f32x4*)sr; ub[i] = *(const GAS f32x4*)(sr + 4); } }
            const bf16* hr = H + (size_t)(rowbase + t) * PROJ; const v4u bg = *(const GAS v4u*)(hr + H_BG + ch0), gc = *(const GAS v4u*)(hr + H_GC + ch0);
            const f32x4 ya = w0a * ua[0] + w1a * ua[1] + w2a * ua[2], yb = w0b * ub[0] + w1b * ub[1] + w2b * ub[2];
            f32x4 oa, ob;
            oa.x = bf_lo(bg.x) * ya.x * silu_f(bf_lo(gc.x)); oa.y = bf_hi(bg.x) * ya.y * silu_f(bf_hi(gc.x)); oa.z = bf_lo(bg.y) * ya.z * silu_f(bf_lo(gc.y)); oa.w = bf_hi(bg.y) * ya.w * silu_f(bf_hi(gc.y));
            ob.x = bf_lo(bg.z) * yb.x * silu_f(bf_lo(gc.z)); ob.y = bf_hi(bg.z) * yb.y * silu_f(bf_hi(gc.z)); ob.z = bf_lo(bg.w) * yb.z * silu_f(bf_lo(gc.w)); ob.w = bf_hi(bg.w) * yb.w * silu_f(bf_hi(gc.w));
            *(GAS v4u*)(MIX + (size_t)(rowbase + t) * DMODEL + ATT + ch0) = pack8(oa, ob);
            if (t >= DECSEQ - 2) { float* cs = F.out + O_CS + ((size_t)(layer * DECB + bn) * 2 + (t - (DECSEQ - 2))) * CONVD + ch0; *(GAS f32x4*)cs = ua[2]; *(GAS f32x4*)(cs + 4) = ub[2]; }
        }
    }
    if (is_prompt) {
#pragma unroll
        for (int i = 0; i < 3; ++i) { const int idx = tid + 512 * i, row = idx >> 3, ch = idx & 7, pos = q0 - 128 + row;
            v4u kv = (v4u){0u, 0u, 0u, 0u}, vv = kv;
            if (pos >= 0) { const bf16* hr = H + (size_t)(rowbase + pos) * PROJ + kvh * 64 + ch * 8; kv = *(const GAS v4u*)(hr + H_K); vv = *(const GAS v4u*)(hr + H_V); }
            *(LAS v4u*)(Kt + row * TROW + ch * 16) = kv; *(LAS v4u*)(Vt + row * TROW + ch * 16) = vv; }
    } else {
#pragma unroll
        for (int i = 0; i < 3; ++i) { const int idx = tid + 512 * i, row = idx >> 3, ch = idx & 7;
            if (idx < 160 * 8) { v4u kv = (v4u){0u, 0u, 0u, 0u}, vv = kv;
                if (row < WINDOW) { const size_t off = (((size_t)(layer * DECB + bn) * WINDOW + row) * NKV + kvh) * 64 + ch * 8;
                    const f32x4 k0 = *(const GAS f32x4*)(F.cache_k + off), k1 = *(const GAS f32x4*)(F.cache_k + off + 4), v0 = *(const GAS f32x4*)(F.cache_v + off), v1 = *(const GAS f32x4*)(F.cache_v + off + 4);
                    kv = pack8(k0, k1); vv = pack8(v0, v1); }
                else if (row < WINDOW + DECSEQ) { const int t = row - WINDOW; const bf16* hr = H + (size_t)(rowbase + t) * PROJ + kvh * 64 + ch * 8; kv = *(const GAS v4u*)(hr + H_K); vv = *(const GAS v4u*)(hr + H_V);
                    const size_t oo = (((size_t)(layer * DECB + bn) * WINDOW + (WINDOW - DECSEQ + t)) * NKV + kvh) * 64 + ch * 8;
                    *(GAS f32x4*)(F.out + O_KWS + oo) = (f32x4){bf_lo(kv.x), bf_hi(kv.x), bf_lo(kv.y), bf_hi(kv.y)}; *(GAS f32x4*)(F.out + O_KWS + oo + 4) = (f32x4){bf_lo(kv.z), bf_hi(kv.z), bf_lo(kv.w), bf_hi(kv.w)};
                    *(GAS f32x4*)(F.out + O_VWS + oo) = (f32x4){bf_lo(vv.x), bf_hi(vv.x), bf_lo(vv.y), bf_hi(vv.y)}; *(GAS f32x4*)(F.out + O_VWS + oo + 4) = (f32x4){bf_lo(vv.z), bf_hi(vv.z), bf_lo(vv.w), bf_hi(vv.w)}; }
                *(LAS v4u*)(Kt + row * TROW + ch * 16) = kv; *(LAS v4u*)(Vt + row * TROW + ch * 16) = vv; } }
    }
    __syncthreads();
    if (is_prompt || wave < 4) {
        int r = lane & 31, h = lane >> 5; asm volatile("" : "+v"(r), "+v"(h));
        const int g = is_prompt ? (wave >> 1) : wave, sub = is_prompt ? 32 * (wave & 1) : 0, hd = kvh * 4 + g;
        const int qrow0 = is_prompt ? rowbase + q0 + sub : rowbase;
        const int qpos0 = is_prompt ? q0 + sub : WINDOW;
        const int nvalid = is_prompt ? min(32, LSEQ - qpos0) : DECSEQ;
        const float slope_l2 = exp2f(-0.5f * (float)(hd + 1)) * 1.4426950408889634f, sink_l2 = F.sinks[layer * NHEADS + hd] * 1.4426950408889634f;
        constexpr float SC = 0.125f * 1.4426950408889634f;
        bf16x8 qf[4];
        { const bf16* qp = H + (size_t)(qrow0 + r) * PROJ + hd * 64 + 8 * h;
#pragma unroll
          for (int d0 = 0; d0 < 4; ++d0) qf[d0] = *(const GAS bf16x8*)(qp + 16 * d0); }
        f32x16 s[5];
#pragma unroll
        for (int j = 0; j < 5; ++j) { s[j] = (f32x16){0.f, 0.f, 0.f, 0.f, 0.f, 0.f, 0.f, 0.f, 0.f, 0.f, 0.f, 0.f, 0.f, 0.f, 0.f, 0.f};
            const LAS unsigned char* kp = Kt + (sub + 32 * j + r) * TROW + 16 * h;
#pragma unroll
            for (int d0 = 0; d0 < 4; ++d0) { const bf16x8 kf = *(const LAS bf16x8*)(kp + 32 * d0); s[j] = __builtin_amdgcn_mfma_f32_32x32x16_bf16(kf, qf[d0], s[j], 0, 0, 0); }
            asm volatile("" ::: "memory"); }
        float mx = sink_l2;
        constexpr unsigned NEGB = 0xF149F2CAu;
#pragma unroll
        for (int j = 0; j < 5; ++j) {
            const int lo = (j == 0) ? max(r + 1, 128 - qpos0) : (128 - 32 * j - qpos0);
            const float dbase = (float)(128 - 32 * j + r);
#pragma unroll
            for (int i = 0; i < 16; ++i) { const int ki = crow(i, h); const int x = (j == 4) ? (r - ki) : (ki - lo);
                const float bias = __uint_as_float((unsigned)(x >> 31) & NEGB);
                const float t = (s[j][i] * SC - slope_l2 * (dbase - (float)ki)) + bias; s[j][i] = t; mx = fmaxf(mx, t); }
            asm volatile("" : "+v"(s[j]), "+v"(mx));
        }
        mx = fmaxf(mx, __shfl_xor(mx, 32));
        float sum = 0.f;
#pragma unroll
        for (int j = 0; j < 5; ++j)
#pragma unroll
            for (int i = 0; i < 16; ++i) { const float p = __builtin_amdgcn_exp2f(s[j][i] - mx); s[j][i] = p; sum += p; }
        sum += __shfl_xor(sum, 32);
        const float inv = 1.0f / (sum + __builtin_amdgcn_exp2f(sink_l2 - mx));
        f32x16 o[2];
        o[0] = (f32x16){0.f, 0.f, 0.f, 0.f, 0.f, 0.f, 0.f, 0.f, 0.f, 0.f, 0.f, 0.f, 0.f, 0.f, 0.f, 0.f}; o[1] = o[0];
        const int q4 = (lane & 15) >> 2, p4 = lane & 3, gb = (lane >> 4) & 1;
        const LAS unsigned char* vp = Vt + (sub + 4 * h + q4) * TROW + (16 * gb + 4 * p4) * 2;
#pragma unroll
        for (int j = 0; j < 5; ++j)
#pragma unroll
            for (int s2 = 0; s2 < 2; ++s2) {
                v4u pw; pw.x = pg8::cvt_pk_bf16(s[j][8 * s2 + 0], s[j][8 * s2 + 1]); pw.y = pg8::cvt_pk_bf16(s[j][8 * s2 + 2], s[j][8 * s2 + 3]);
                pw.z = pg8::cvt_pk_bf16(s[j][8 * s2 + 4], s[j][8 * s2 + 5]); pw.w = pg8::cvt_pk_bf16(s[j][8 * s2 + 6], s[j][8 * s2 + 7]);
                const bf16x8 pf = __builtin_bit_cast(bf16x8, pw);
#pragma unroll
                for (int db = 0; db < 2; ++db) { const LAS unsigned char* a = vp + (32 * j + 16 * s2) * TROW + 64 * db;
                    const s16x4 lo = vtr(a), hi = vtr(a + 8 * TROW);
                    const bf16x8 vf = (bf16x8){lo[0], lo[1], lo[2], lo[3], hi[0], hi[1], hi[2], hi[3]};
                    o[db] = __builtin_amdgcn_mfma_f32_32x32x16_bf16(vf, pf, o[db], 0, 0, 0); }
                asm volatile("" ::: "memory"); }
        LAS unsigned char* st = F.lds + ST_OFF + wave * ST_WAVE;
#pragma unroll
        for (int db = 0; db < 2; ++db)
#pragma unroll
            for (int ig = 0; ig < 4; ++ig) { pg8::u32x2v w; w.x = pg8::cvt_pk_bf16(o[db][4 * ig] * inv, o[db][4 * ig + 1] * inv); w.y = pg8::cvt_pk_bf16(o[db][4 * ig + 2] * inv, o[db][4 * ig + 3] * inv);
                *(LAS pg8::u32x2v*)(st + r * TROW + (32 * db + 8 * ig + 4 * h) * 2) = w; }
        asm volatile("s_waitcnt lgkmcnt(0)" ::: "memory");
#pragma unroll
        for (int it = 0; it < 4; ++it) { const int row = it * 8 + (lane >> 3), ch = lane & 7;
            const v4u ov = *(const LAS v4u*)(st + row * TROW + ch * 16);
            if (row < nvalid) { const v4u gv = *(const GAS v4u*)(H + (size_t)(qrow0 + row) * PROJ + H_GA + hd * 64 + ch * 8);
                f32x4 a, b;
                a.x = bf_lo(ov.x) * silu_f(bf_lo(gv.x)); a.y = bf_hi(ov.x) * silu_f(bf_hi(gv.x)); a.z = bf_lo(ov.y) * silu_f(bf_lo(gv.y)); a.w = bf_hi(ov.y) * silu_f(bf_hi(gv.y));
                b.x = bf_lo(ov.z) * silu_f(bf_lo(gv.z)); b.y = bf_hi(ov.z) * silu_f(bf_hi(gv.z)); b.z = bf_lo(ov.w) * silu_f(bf_lo(gv.w)); b.w = bf_hi(ov.w) * silu_f(bf_hi(gv.w));
                *(GAS v4u*)(MIX + (size_t)(qrow0 + row) * DMODEL + hd * 64 + ch * 8) = pack8(a, b); } }
    }
    __syncthreads();
}
__device__ __forceinline__ void attn_conv_phase(Frame& F0, int layer) {
    Frame F = F0; asm volatile("" : "+v"(F.tid)); F.lane = F.tid & 63;
    for (int u = blockIdx.x; u < N_UNITS; u += F.G) attn_conv_unit(F, layer, u);
    const int gt = blockIdx.x * (NWAVES * 64) + F.tid, NGT = F.G * NWAVES * 64;
    for (int e = gt; e < NB * WINDOW * 2 * KVDIM / 4; e += NGT) { const int b = e / (WINDOW * 2 * KVDIM / 4), r = e - b * (WINDOW * 2 * KVDIM / 4), i = r / (2 * KVDIM / 4), c = (r - i * (2 * KVDIM / 4)) * 4;
        const unsigned long long w = *(const GAS unsigned long long*)(F.H + (size_t)(b * LSEQ + LSEQ - WINDOW + i) * PROJ + H_K + c);
        const unsigned lo = (unsigned)w, hi = (unsigned)(w >> 32);
        float* dst = F.out + (c < KVDIM ? O_KWP : O_VWP) + ((size_t)(layer * NB + b) * WINDOW + i) * KVDIM + (c < KVDIM ? c : c - KVDIM);
        *(GAS f32x4*)dst = (f32x4){bf_lo(lo), bf_hi(lo), bf_lo(hi), bf_hi(hi)}; }
}
__device__ __forceinline__ void final_ln_phase(Frame& F) {
    const int gw = blockIdx.x * NWAVES + F.wave, NGW = F.G * NWAVES, lane = F.lane;
    const float* st = F.XST + (size_t)((DEPTH - 1) & 1) * MPAD * 16; const float* g = F.ln_g + (DEPTH - 1) * DMODEL; const float* b = F.ln_b + (DEPTH - 1) * DMODEL;
    for (int m = gw; m < MV; m += NGW) {
        float* dst;
        if (m < MP) { const int bb = m / LSEQ, pos = m - bb * LSEQ; if (pos < NMETA) continue; dst = F.out + O_YP + ((size_t)bb * SEQ + (pos - NMETA)) * DMODEL; }
        else dst = F.out + O_YS + (size_t)(m - MP) * DMODEL;
        float mu, rs; pg8::row_stats(st + (size_t)m * 16, mu, rs);
        const GAS f32x4* yr = (const GAS f32x4*)(F.Y + (size_t)m * DMODEL) + lane;
#pragma unroll
        for (int j = 0; j < 8; ++j) { const f32x4 v = yr[64 * j], gg = ((const GAS f32x4*)g)[lane + 64 * j], bb2 = ((const GAS f32x4*)b)[lane + 64 * j];
            ((GAS f32x4*)dst)[lane + 64 * j] = (v - mu) * rs * gg + bb2; }
    }
}

struct Args { const float* in[12]; float* out; unsigned char* ws; int ph_lo, ph_hi, li, pad; };
__global__ void __launch_bounds__(NWAVES * 64, 2) hymba_fwd(Args args) {
    extern __shared__ __attribute__((aligned(16))) unsigned char lds[];
    Frame F;
    F.lds = (LAS unsigned char*)lds;
    F.MISC = (volatile LAS unsigned*)(F.lds + MISC_OFF);
    F.tid = threadIdx.x; F.lane = F.tid & 63; F.wave = __builtin_amdgcn_readfirstlane(F.tid >> 6); F.G = gridDim.x;
    unsigned char* ws = args.ws;
    F.ctl = (gu32*)(ws + WS_CTL);
    F.x_prompt = args.in[0]; F.x_sample = args.in[1]; F.cache_k = args.in[2]; F.cache_v = args.in[3]; F.state_conv = args.in[4]; F.meta = args.in[5];
    F.w_in = args.in[6]; F.conv_w = args.in[7]; F.sinks = args.in[8]; F.w_out = args.in[9]; F.ln_g = args.in[10]; F.ln_b = args.in[11]; F.out = args.out;
    F.WtIn = (bf16*)(ws + WS_WTIN); F.WtOut = (bf16*)(ws + WS_WTOUT); F.Yb = (bf16*)(ws + WS_YB); F.H = (bf16*)(ws + WS_H); F.MIX = (bf16*)(ws + WS_MIX);
    F.Y = (float*)(ws + WS_Y); F.XST = (float*)(ws + WS_XST); F.C1 = (float*)(ws + WS_C1); F.C2 = (float*)(ws + WS_C2);
    for (int u = F.tid; u < (LDS_BYTES - LDSCTL_OFF) / 4; u += NWAVES * 64) ((LAS unsigned*)(F.lds + LDSCTL_OFF))[u] = 0u;
    __syncthreads();
    const bool one_launch = (args.ph_hi - args.ph_lo) > 1;
    XcdBarrier bar; bar.bar = (unsigned*)(F.ctl + CW_BAR); bar.x = 0; bar.st = nullptr;
    if (one_launch) bar = xcd_barrier_post((unsigned*)(F.ctl + CW_BAR), F.MISC + 8);
    const int lo = args.ph_lo, hi = args.ph_hi;
#define IN(k) (lo <= (k) && (k) < hi)
#define SEAM(k) do { if (IN(k) && IN((k) + 1)) xcd_barrier(bar); } while (0)
    #ifndef NO_P0
    if (IN(0)) { p0_prologue(F); }
#endif
    SEAM(0);
    for (int l = 0; l < DEPTH; ++l) {
        const int pa = 1 + 3 * l;
#ifndef NO_GEMMA
        if (IN(pa)) {
            pg8::Gemm g{F.Yb, F.WtIn + (size_t)l * PROJ * DMODEL, MPAD, PROJ, DMODEL}; pg8::StaticOrder S; S.init(MPAD, PROJ, F.G, (int)blockIdx.x);
            pg8::EpiH E{F.H, PROJ, F.C1 + l * PROJ, F.C2 + l * PROJ, F.XST + (size_t)((l + 1) & 1) * MPAD * 16, l > 0 ? 1 : 0};
            pg8::gemm_phase<pg8::EpiH, pg8::StaticOrder, true, true>(F.lds, g, S, E);
        }
#endif
        SEAM(pa);
#ifndef NO_ATTN
        if (IN(pa + 1)) attn_conv_phase(F, l);
#endif
        SEAM(pa + 1);
#ifndef NO_GEMMC
        if (IN(pa + 2)) {
            pg8::Gemm g{F.MIX, F.WtOut + (size_t)l * DMODEL * DMODEL, MPAD, DMODEL, DMODEL}; pg8::StaticOrder S; S.init(MPAD, DMODEL, F.G, (int)blockIdx.x);
            pg8::EpiY E{F.Y, F.Yb, F.XST + (size_t)((l + 1) & 1) * MPAD * 16, F.XST + (size_t)(l & 1) * MPAD * 16, F.ln_g + (l > 0 ? l - 1 : 0) * DMODEL, F.ln_b + (l > 0 ? l - 1 : 0) * DMODEL, l > 0 ? 1 : 0, ALPHA, F.lds + XLDS_OFF};
            pg8::gemm_phase<pg8::EpiY, pg8::StaticOrder, true, true>(F.lds, g, S, E);
        }
#endif
        SEAM(pa + 2);
    }
#ifndef NO_FIN
    if (IN(1 + 3 * DEPTH)) final_ln_phase(F);
#endif
#undef IN
#undef SEAM
}

extern "C" void kernel_launch(void* const* d_in, const int* in_sizes, int n_in, void* d_out, int out_size, void* d_ws, size_t ws_size, hipStream_t stream) {
    static int grid = 0;
    if (grid == 0) {
        if (n_in != 12 || out_size != O_TOTAL || ws_size < WS_END) { fprintf(stderr, "kernel_launch: unexpected shapes (n_in %d, out %d, ws %zu)\n", n_in, out_size, ws_size); grid = -1; return; }
        int dev = 0, cus = 0, per_cu = 0;
        if (hipGetDevice(&dev) != hipSuccess || hipDeviceGetAttribute(&cus, hipDeviceAttributeMultiprocessorCount, dev) != hipSuccess) { grid = -1; return; }
        if (hipFuncSetAttribute((const void*)hymba_fwd, hipFuncAttributeMaxDynamicSharedMemorySize, LDS_BYTES) != hipSuccess) { fprintf(stderr, "kernel_launch: hipFuncSetAttribute failed\n"); grid = -1; return; }
        if (hipOccupancyMaxActiveBlocksPerMultiprocessor(&per_cu, (const void*)hymba_fwd, NWAVES * 64, LDS_BYTES) != hipSuccess || per_cu < 1) { fprintf(stderr, "kernel_launch: occupancy query says %d blocks per CU\n", per_cu); (void)hipGetLastError(); grid = -1; return; }
        grid = cus;
    }
    if (grid < 0) return;
    (void)hipMemsetAsync((char*)d_ws + WS_CTL, 0, CTL_ZERO_BYTES, stream);
    Args a{};
    for (int i = 0; i < 12; ++i) a.in[i] = (const float*)d_in[i];
    a.out = (float*)d_out; a.ws = (unsigned char*)d_ws;
    constexpr int NPH = 2 + 3 * DEPTH;
#if N_LAUNCHES == 1
    a.ph_lo = 0; a.ph_hi = NPH; a.li = 0;
    hipLaunchKernelGGL(hymba_fwd, dim3(grid), dim3(NWAVES * 64), LDS_BYTES, stream, a);
#else
    for (int p = 0; p < NPH; ++p) { a.ph_lo = p; a.ph_hi = p + 1; a.li = p; hipLaunchKernelGGL(hymba_fwd, dim3(grid), dim3(NWAVES * 64), LDS_BYTES, stream, a); }
#endif
}
```

```cpp
#include <hip/hip_runtime.h>
#include <hip/hip_bf16.h>
#include <cstdio>
#include <cstdint>
#include <cmath>

#ifndef PROBE_DUP_ATTN
#define PROBE_DUP_ATTN 0
#endif
#ifndef PROBE_DUP_INPROJ
#define PROBE_DUP_INPROJ 0
#endif
#ifndef PROBE_DUP_P0
#define PROBE_DUP_P0 0
#endif
#ifndef PROBE_DUP_OUTPROJ
#define PROBE_DUP_OUTPROJ 0
#endif
#ifndef N_LAUNCHES
#define N_LAUNCHES 1
#endif

constexpr int DMODEL = 2048, NB = 2, SEQ = 4096, DEPTH = 4, DECB = 32, DECSEQ = 4, NMETA = 16;
constexpr int ATT = 1024, CONVD = 1024, HD = 64, NHEADS = 16, NKV = 4, KVDIM = NKV * HD, WINDOW = 128;
constexpr int PROJ = ATT + 2 * KVDIM + ATT + 4 * CONVD;
constexpr int LSEQ = NMETA + SEQ;
constexpr int MP = NB * LSEQ, MS = DECB * DECSEQ, MV = MP + MS;
constexpr int MPAD = 8448;
constexpr int H_Q = 0, H_K = ATT, H_V = ATT + KVDIM, H_GA = ATT + 2 * KVDIM, H_BG = H_GA + ATT, H_CG = H_BG + CONVD, H_HC = H_CG + CONVD, H_GC = H_HC + CONVD;
constexpr float ALPHA = 1.6817928305074290861f;
constexpr int O_YP = 0, O_YS = O_YP + NB * SEQ * DMODEL, O_KWP = O_YS + MS * DMODEL, O_VWP = O_KWP + DEPTH * NB * WINDOW * KVDIM, O_CP = O_VWP + DEPTH * NB * WINDOW * KVDIM,
              O_KWS = O_CP + DEPTH * NB * 2 * CONVD, O_VWS = O_KWS + DEPTH * DECB * WINDOW * KVDIM, O_CS = O_VWS + DEPTH * DECB * WINDOW * KVDIM, O_TOTAL = O_CS + DEPTH * DECB * 2 * CONVD;
static_assert(O_TOTAL == 26230784, "output size");
constexpr size_t MiB = 1u << 20;
constexpr size_t WS_CTL = 0, CTL_ZERO_BYTES = 1 * MiB;
constexpr size_t WS_C1 = 256 * 1024, WS_C2 = 512 * 1024;
constexpr size_t WS_XST = 2 * MiB;
constexpr size_t WS_WTIN = 4 * MiB;
constexpr size_t WS_WTOUT = 108 * MiB;
constexpr size_t WS_Y = 140 * MiB;
constexpr size_t WS_YB = 206 * MiB;
constexpr size_t WS_MIX = 239 * MiB;
constexpr size_t WS_H = 272 * MiB;
constexpr size_t WS_END = 380 * MiB;
static_assert(WS_C1 + (size_t)DEPTH * PROJ * 4 <= WS_C2 && WS_C2 + (size_t)DEPTH * PROJ * 4 <= CTL_ZERO_BYTES, "c1/c2");
static_assert(WS_XST + (size_t)2 * MPAD * 16 * 4 <= WS_WTIN && WS_WTIN + (size_t)DEPTH * PROJ * DMODEL * 2 <= WS_WTOUT && WS_WTOUT + (size_t)DEPTH * DMODEL * DMODEL * 2 <= WS_Y, "ws map 1");
static_assert(WS_Y + (size_t)MPAD * DMODEL * 4 <= WS_YB && WS_YB + (size_t)MPAD * DMODEL * 2 <= WS_MIX && WS_MIX + (size_t)MPAD * DMODEL * 2 <= WS_H && WS_H + (size_t)MPAD * PROJ * 2 <= WS_END, "ws map 2");
constexpr int CW_BAR = 4096;
constexpr int NWAVES = 8;
constexpr int RING_BYTES = 131072;
constexpr int LDSCTL_OFF = RING_BYTES, MISC_OFF = LDSCTL_OFF + 320;
constexpr int XLDS_OFF = RING_BYTES + 1024;
constexpr int TAB_OFF = XLDS_OFF + 8192;
constexpr int LDS_BYTES = 151552;
static_assert(TAB_OFF + 8192 <= LDS_BYTES, "LDS map");
namespace pg8 {
#define PG8_LAS __attribute__((address_space(3)))
typedef unsigned short bf16_t;
typedef short bf16x8 __attribute__((ext_vector_type(8)));
typedef float f32x4 __attribute__((ext_vector_type(4)));
typedef unsigned u32x4 __attribute__((ext_vector_type(4)));
constexpr int BM = 256, BK = 64, HALF = 128, HTB = HALF * BK * 2  , STAGE_BYTES = 8 * HTB, NXCD = 8, WGM = 8;

__host__ __device__ __forceinline__ int lds_byte(int r, int c) { const int st = (r >> 4) * 2 + (c >> 5), rr = r & 15, cc = c & 31, ob = rr * 64 + cc * 2; return st * 1024 + (ob ^ (((ob >> 9) & 1) << 5)); }
__host__ __device__ __forceinline__ void stage_rc(int b, int& R, int& C) { const int st = b / 1024, sb = b % 1024, swz = sb ^ (((sb >> 9) & 1) << 5); R = (st >> 1) * 16 + swz / 64; C = (st & 1) * 32 + (swz % 64) / 2; }
__host__ __device__ __forceinline__ int perm32(int rho) { const int n = rho >> 4, i = rho & 15; return 8 * (i >> 2) + 4 * n + (i & 3); }

struct Unit { int pm, pn; };
struct Gemm { const bf16_t* A; const bf16_t* Bt; int M, N, K; };

struct StaticOrder {
    int nM, nN, nwg, G, c;
    __host__ __device__ void init(int M, int N, int G_, int c_) { nM = M / BM; nN = N / BM; nwg = nM * nN; G = G_; c = c_; }
    __host__ __device__ bool next(int i, Unit& u) const {
        const long L = (long)i * G + c; if (L >= nwg) return false;
        int wgid = (int)L; { const int q = nwg / NXCD, r = nwg % NXCD, xcd = wgid % NXCD, off = wgid / NXCD; wgid = (xcd < r ? xcd * (q + 1) : r * (q + 1) + (xcd - r) * q) + off; }
        const int nig = WGM * nN, gid = wgid / nig, fm = gid * WGM, gsz = (nM - fm) < WGM ? (nM - fm) : WGM;
        u.pm = fm + ((wgid % nig) % gsz); u.pn = (wgid % nig) / gsz; return true;
    }
    __device__ __forceinline__ void a_ready(const Unit&) const {}
    __device__ __forceinline__ void done(const Unit&) const {}
};


typedef float f32x2t __attribute__((ext_vector_type(2))); typedef __bf16 bf16x2t __attribute__((ext_vector_type(2)));
__device__ __forceinline__ unsigned cvt_pk_bf16(float lo, float hi) { f32x2t v = {lo, hi}; bf16x2t b = __builtin_convertvector(v, bf16x2t); return __builtin_bit_cast(unsigned, b); }
typedef float f32x2v __attribute__((ext_vector_type(2)));
typedef unsigned u32x2v __attribute__((ext_vector_type(2)));
constexpr float LN_EPS_F = 1e-5f;
constexpr int DM = 2048;
__device__ __forceinline__ void row_stats(const float* st, float& mu, float& rstd) {
    const f32x4 a = *(const f32x4*)(st), b = *(const f32x4*)(st + 4), c = *(const f32x4*)(st + 8), d = *(const f32x4*)(st + 12);
    const float mean = (((a[0] + a[2]) + (b[0] + b[2])) + ((c[0] + c[2]) + (d[0] + d[2]))) * 0.125f;
    float q = ((a[1] + a[3]) + (b[1] + b[3])) + ((c[1] + c[3]) + (d[1] + d[3]));
    float e, s;
    e = a[0] - mean; s = e * e; e = a[2] - mean; s += e * e; e = b[0] - mean; s += e * e; e = b[2] - mean; s += e * e;
    e = c[0] - mean; s += e * e; e = c[2] - mean; s += e * e; e = d[0] - mean; s += e * e; e = d[2] - mean; s += e * e;
    q += 256.0f * s;
    mu = mean; rstd = 1.0f / sqrtf(q * (1.0f / (float)DM) + LN_EPS_F);
}

template <class Sched> __device__ __forceinline__ void fill_stats_table(PG8_LAS f32x2v* tab, const Sched& S, const float* stats, int has_ln, int tid) {
    for (int idx = tid; idx < 4 * BM; idx += 512) { const int i = idx >> 8, r = idx & 255; Unit u;
        if (S.next(i, u)) { float mu = 0.f, rs = 1.f; if (has_ln) row_stats(stats + (size_t)(u.pm * BM + r) * 16, mu, rs); tab[idx] = (f32x2v){mu, rs}; } }
    __syncthreads();
}
struct EpiH {
    static constexpr bool PERM = true, AFTER_DRAIN = false;
    bf16_t* H; int ldc; const float* c1; const float* c2; int has_ln; const PG8_LAS f32x2v* tab;
    __device__ __forceinline__ void init(f32x4 (&acc)[2][2][4][2], const Unit&, int, int, int, int, int) const {
#pragma unroll
        for (int a = 0; a < 2; ++a)
#pragma unroll
            for (int b = 0; b < 2; ++b)
#pragma unroll
                for (int m = 0; m < 4; ++m)
#pragma unroll
                    for (int n = 0; n < 2; ++n) acc[a][b][m][n] = (f32x4){0.f, 0.f, 0.f, 0.f};
    }
    __device__ __forceinline__ void operator()(f32x4 (&acc)[2][2][4][2], const Unit& u, int ui, int wr, int wc, int fr, int fq) const {
        const int row0 = u.pm * BM + wr * 64 + fr, col0 = u.pn * BM + wc * 32 + 8 * fq;
        f32x4 c1v[2][2], c2v[2][2];
#pragma unroll
        for (int bj = 0; bj < 2; ++bj)
#pragma unroll
            for (int n = 0; n < 2; ++n) { c1v[bj][n] = *(const f32x4*)(c1 + col0 + bj * HALF + 4 * n); c2v[bj][n] = *(const f32x4*)(c2 + col0 + bj * HALF + 4 * n);
                if (!has_ln) { c1v[bj][n] = (f32x4){0.f, 0.f, 0.f, 0.f}; c2v[bj][n] = (f32x4){0.f, 0.f, 0.f, 0.f}; } }
        const PG8_LAS f32x2v* tu = tab + ui * BM + wr * 64 + fr;
#pragma unroll
        for (int ai = 0; ai < 2; ++ai)
#pragma unroll
            for (int m = 0; m < 4; ++m) { const int row = row0 + ai * HALF + m * 16; const f32x2v st = tu[ai * HALF + m * 16]; const float mu = st.x, rs = st.y;
                bf16_t* rowp = H + (size_t)row * ldc + col0;
#pragma unroll
                for (int bj = 0; bj < 2; ++bj) { const f32x4 v0 = (acc[ai][bj][m][0] - mu * c1v[bj][0]) * rs + c2v[bj][0], v1 = (acc[ai][bj][m][1] - mu * c1v[bj][1]) * rs + c2v[bj][1];
                    u32x4 w; w.x = cvt_pk_bf16(v0[0], v0[1]); w.y = cvt_pk_bf16(v0[2], v0[3]); w.z = cvt_pk_bf16(v1[0], v1[1]); w.w = cvt_pk_bf16(v1[2], v1[3]);
                    *(u32x4*)(rowp + bj * HALF) = w; } }
    }
};
struct EpiY {
    static constexpr bool PERM = false, AFTER_DRAIN = false;
    float* Y; bf16_t* Yb; float* stats_out; const float* g; const float* b; int has_ln; float alpha; PG8_LAS unsigned char* xlds; const float* Ysrc; const PG8_LAS f32x2v* tab;
    __device__ __forceinline__ void init(f32x4 (&acc)[2][2][4][2], const Unit& u, int ui, int wr, int wc, int fr, int fq) const {
        const int col0 = u.pn * BM + wc * 32 + 4 * fq;
        const float* ybase = Ysrc + (size_t)(u.pm * BM + wr * 64 + fr) * DM + col0;
#pragma unroll
        for (int ai = 0; ai < 2; ++ai)
#pragma unroll
            for (int m = 0; m < 4; ++m)
#pragma unroll
                for (int bj = 0; bj < 2; ++bj)
#pragma unroll
                    for (int n = 0; n < 2; ++n) acc[ai][bj][m][n] = *(const f32x4*)(ybase + (size_t)(ai * HALF + m * 16) * DM + bj * HALF + n * 16);
        const PG8_LAS f32x2v* tu = tab + ui * BM + wr * 64 + fr;
#pragma unroll
        for (int bj = 0; bj < 2; ++bj)
#pragma unroll
            for (int n = 0; n < 2; ++n) { f32x4 gv = *(const f32x4*)(g + col0 + bj * HALF + n * 16), bv = *(const f32x4*)(b + col0 + bj * HALF + n * 16);
                if (!has_ln) { gv = (f32x4){1.f, 1.f, 1.f, 1.f}; bv = (f32x4){0.f, 0.f, 0.f, 0.f}; }
                gv = gv * alpha; bv = bv * alpha;
#pragma unroll
                for (int ai = 0; ai < 2; ++ai)
#pragma unroll
                    for (int m = 0; m < 4; ++m) { const f32x2v st = tu[ai * HALF + m * 16]; acc[ai][bj][m][n] = (acc[ai][bj][m][n] - st.x) * st.y * gv + bv; } }
    }
    __device__ __forceinline__ void operator()(f32x4 (&acc)[2][2][4][2], const Unit& u, int ui, int wr, int wc, int fr, int fq) const {
        const int col0 = u.pn * BM + wc * 32 + 4 * fq;
        PG8_LAS f32x2v* P = (PG8_LAS f32x2v*)xlds;
#pragma unroll
        for (int ai = 0; ai < 2; ++ai)
#pragma unroll
            for (int m = 0; m < 4; ++m) {
                float s = 0.f;
#pragma unroll
                for (int bj = 0; bj < 2; ++bj)
#pragma unroll
                    for (int n = 0; n < 2; ++n) { const f32x4 x = acc[ai][bj][m][n]; s += (x[0] + x[1]) + (x[2] + x[3]); }
                s += __shfl_xor(s, 16); s += __shfl_xor(s, 32);
                const float mw = s * (1.0f / 64.0f); float q = 0.f;
#pragma unroll
                for (int bj = 0; bj < 2; ++bj)
#pragma unroll
                    for (int n = 0; n < 2; ++n) { const f32x4 d = acc[ai][bj][m][n] - mw; q += (d[0] * d[0] + d[1] * d[1]) + (d[2] * d[2] + d[3] * d[3]); }
                q += __shfl_xor(q, 16); q += __shfl_xor(q, 32);
                if (fq == 0) P[(ai * HALF + wr * 64 + m * 16 + fr) * 4 + wc] = (f32x2v){mw, q};
            }
        asm volatile("s_waitcnt lgkmcnt(0)" ::: "memory"); __builtin_amdgcn_s_barrier(); asm volatile("" ::: "memory");
        { const int wid = wr * 4 + wc, lane = fq * 16 + fr, row = wid * 32 + (lane & 31);
          if (lane < 32) {
            const f32x2v a = P[row * 4 + 0], b2 = P[row * 4 + 1], c = P[row * 4 + 2], d = P[row * 4 + 3];
            const float mt = ((a.x + b2.x) + (c.x + d.x)) * 0.25f;
            const float da = a.x - mt, db = b2.x - mt, dc = c.x - mt, dd = d.x - mt;
            const float m2 = ((a.y + b2.y) + (c.y + d.y)) + 64.0f * ((da * da + db * db) + (dc * dc + dd * dd));
            *(f32x2v*)(stats_out + ((size_t)(u.pm * BM + row) * 8 + u.pn) * 2) = (f32x2v){mt, m2};
          } }
#pragma unroll
        for (int ai = 0; ai < 2; ++ai)
#pragma unroll
            for (int m = 0; m < 4; ++m) { const size_t off = (size_t)(u.pm * BM + ai * HALF + wr * 64 + m * 16 + fr) * DM + col0;
#pragma unroll
                for (int bj = 0; bj < 2; ++bj)
#pragma unroll
                    for (int n = 0; n < 2; ++n) { const f32x4 y = acc[ai][bj][m][n]; *(f32x4*)(Y + off + bj * HALF + n * 16) = y;
                        u32x2v w; w.x = cvt_pk_bf16(y[0], y[1]); w.y = cvt_pk_bf16(y[2], y[3]); *(u32x2v*)(Yb + off + bj * HALF + n * 16) = w; } }
    }
};
template <class Epi, class Sched, bool ALIGN_EPI = false, bool SP2 = false>
__device__ __forceinline__ void gemm_phase(PG8_LAS unsigned char* lds, const Gemm g, const Sched& S, const Epi& E) {
    int tid = threadIdx.x; asm volatile("" : "+v"(tid));
    const int wid = __builtin_amdgcn_readfirstlane(tid >> 6), lane = tid & 63, wr = wid >> 2, wc = wid & 3, fr = lane & 15, fq = lane >> 4;
    const int K = g.K, nt = K / BK;
    unsigned voffA[2], voffB[2];
#pragma unroll
    for (int i = 0; i < 2; ++i) { int R, C; stage_rc(tid * 16 + i * 8192, R, C); const int Rb = Epi::PERM ? ((R & ~31) + perm32(R & 31)) : R;
        voffA[i] = (unsigned)(R * K + C) * 2u; voffB[i] = (unsigned)(Rb * K + C) * 2u; }
    const size_t kstep = (size_t)(BK * 2);
    const size_t hstep = (size_t)HALF * K * 2;
    const size_t tstep = 2 * hstep;
    const unsigned ldsw = (unsigned)wid * 1024u;
    const int aoff = lds_byte(wr * 64 + fr, fq * 8), boff = lds_byte(wc * 32 + fr, fq * 8);
#define PG8_SA(b, h) (((b) * 2 + (h)) * HTB)
#define PG8_SB(b, h) ((4 + (b) * 2 + (h)) * HTB)
#define PG8_STAGE(bufoff, gbase, voff) do { _Pragma("unroll") for (int _i = 0; _i < 2; ++_i) \
        __builtin_amdgcn_global_load_lds((const unsigned*)((const char*)(gbase) + (voff)[_i]), (PG8_LAS unsigned*)(lds + (bufoff) + ldsw + _i * 8192), 16, 0, 0); } while (0)
#define PG8_LDA(dst, b, h) do { _Pragma("unroll") for (int m = 0; m < 4; ++m) _Pragma("unroll") for (int k = 0; k < 2; ++k) dst[m][k] = *(const PG8_LAS bf16x8*)(lds + PG8_SA(b, h) + aoff + m * 2048 + k * 1024); } while (0)
#define PG8_LDB(dst, b, h) do { _Pragma("unroll") for (int n = 0; n < 2; ++n) _Pragma("unroll") for (int k = 0; k < 2; ++k) dst[n][k] = *(const PG8_LAS bf16x8*)(lds + PG8_SB(b, h) + boff + n * 2048 + k * 1024); } while (0)
#define PG8_MMA(ai, bj, At, Bt) do { __builtin_amdgcn_s_setprio(1); _Pragma("unroll") for (int m = 0; m < 4; ++m) _Pragma("unroll") for (int n = 0; n < 2; ++n) _Pragma("unroll") for (int k = 0; k < 2; ++k) \
        acc[ai][bj][m][n] = __builtin_amdgcn_mfma_f32_16x16x32_bf16(Bt[n][k], At[m][k], acc[ai][bj][m][n], 0, 0, 0); __builtin_amdgcn_s_setprio(0); } while (0)
#define PG8_WAIT_V(n) asm volatile("s_waitcnt vmcnt(" #n ")" ::: "memory")
#define PG8_WAIT_L(n) asm volatile("s_waitcnt lgkmcnt(" #n ")" ::: "memory")
#define PG8_BAR __builtin_amdgcn_s_barrier()
#define PG8_SCHED __builtin_amdgcn_sched_barrier(0)
    Unit cur, nxt; int ui = 0;
    if (!S.next(0, cur)) return;
    f32x4 acc[2][2][4][2];
    E.init(acc, cur, 0, wr, wc, fr, fq);
    bf16x8 At[4][2], B0[2][2], B1[2][2];
    const char* cA = (const char*)g.A + (size_t)cur.pm * tstep; const char* cB = (const char*)g.Bt + (size_t)cur.pn * tstep;
    S.a_ready(cur);
    if constexpr (SP2) {
        PG8_STAGE(PG8_SB(0, 0), cB, voffB); PG8_STAGE(PG8_SB(0, 1), cB + hstep, voffB); PG8_STAGE(PG8_SA(0, 0), cA, voffA); PG8_STAGE(PG8_SA(0, 1), cA + hstep, voffA);
        if (wr == 1) PG8_BAR;
        PG8_WAIT_V(2); PG8_BAR;
        PG8_STAGE(PG8_SB(1, 0), cB + kstep, voffB); PG8_STAGE(PG8_SA(1, 0), cA + kstep, voffA); PG8_STAGE(PG8_SB(1, 1), cB + hstep + kstep, voffB);
        PG8_WAIT_V(6); PG8_BAR;
    } else {
        PG8_STAGE(PG8_SB(0, 0), cB, voffB); PG8_STAGE(PG8_SA(0, 0), cA, voffA); PG8_STAGE(PG8_SB(0, 1), cB + hstep, voffB); PG8_STAGE(PG8_SA(0, 1), cA + hstep, voffA);
        if (wr == 1) PG8_BAR;
        PG8_WAIT_V(4); PG8_BAR;
        PG8_STAGE(PG8_SB(1, 0), cB + kstep, voffB); PG8_STAGE(PG8_SA(1, 0), cA + kstep, voffA); PG8_STAGE(PG8_SB(1, 1), cB + hstep + kstep, voffB);
        PG8_WAIT_V(6); PG8_BAR;
    }
    for (;;) {
        const bool has_next = S.next(ui + 1, nxt);
        const char* nA = has_next ? (const char*)g.A + (size_t)nxt.pm * tstep : cA; const char* nB = has_next ? (const char*)g.Bt + (size_t)nxt.pn * tstep : cB;
        for (int t = 0; t < nt; t += 2) {
            const bool last = (t == nt - 2);
            const char* a1 = cA + (size_t)(t + 1) * kstep;
            const char* a2 = last ? nA : cA + (size_t)(t + 2) * kstep; const char* b2 = last ? nB : cB + (size_t)(t + 2) * kstep;
            const char* a3 = a2 + kstep; const char* b3 = b2 + kstep;
            if (last && has_next) S.a_ready(nxt);
            if constexpr (SP2) {
            PG8_LDB(B0, 0, 0); PG8_LDB(B1, 0, 1); PG8_SCHED; PG8_LDA(At, 0, 0); PG8_STAGE(PG8_SA(1, 1), a1 + hstep, voffA);
            PG8_WAIT_V(8); PG8_WAIT_L(0); PG8_BAR; PG8_MMA(0, 0, At, B0); PG8_MMA(0, 1, At, B1); PG8_BAR; PG8_SCHED;
            PG8_LDA(At, 0, 1); PG8_STAGE(PG8_SB(0, 0), b2, voffB); PG8_STAGE(PG8_SB(0, 1), b2 + hstep, voffB); PG8_STAGE(PG8_SA(0, 0), a2, voffA);
            PG8_WAIT_V(8); PG8_WAIT_L(0); PG8_BAR; PG8_MMA(1, 0, At, B0); PG8_MMA(1, 1, At, B1); PG8_BAR; PG8_SCHED;
            PG8_LDB(B0, 1, 0); PG8_LDB(B1, 1, 1); PG8_SCHED; PG8_LDA(At, 1, 0); PG8_STAGE(PG8_SA(0, 1), a2 + hstep, voffA);
            PG8_WAIT_V(8); PG8_WAIT_L(0); PG8_BAR; PG8_MMA(0, 0, At, B0); PG8_MMA(0, 1, At, B1); PG8_BAR; PG8_SCHED;
            PG8_LDA(At, 1, 1); PG8_STAGE(PG8_SB(1, 0), b3, voffB); PG8_STAGE(PG8_SB(1, 1), b3 + hstep, voffB); PG8_STAGE(PG8_SA(1, 0), a3, voffA);
            PG8_WAIT_V(8); PG8_WAIT_L(0); PG8_BAR; PG8_MMA(1, 0, At, B0); PG8_MMA(1, 1, At, B1); PG8_BAR; PG8_SCHED;
            } else {
            PG8_LDB(B0, 0, 0); PG8_SCHED; PG8_LDA(At, 0, 0); PG8_STAGE(PG8_SA(1, 1), a1 + hstep, voffA);
            PG8_WAIT_L(8); PG8_BAR; PG8_WAIT_L(0); PG8_MMA(0, 0, At, B0); PG8_BAR; PG8_SCHED;
            PG8_LDB(B1, 0, 1); PG8_STAGE(PG8_SB(0, 0), b2, voffB);
            PG8_BAR; PG8_WAIT_L(0); PG8_MMA(0, 1, At, B1); PG8_BAR;
            PG8_LDA(At, 0, 1); PG8_STAGE(PG8_SA(0, 0), a2, voffA);
            PG8_BAR; PG8_WAIT_L(0); PG8_MMA(1, 0, At, B0); PG8_BAR; PG8_SCHED;
            PG8_STAGE(PG8_SB(0, 1), b2 + hstep, voffB);
            PG8_WAIT_V(6); PG8_BAR; PG8_MMA(1, 1, At, B1); PG8_BAR;
            PG8_LDB(B0, 1, 0); PG8_SCHED; PG8_LDA(At, 1, 0); PG8_STAGE(PG8_SA(0, 1), a2 + hstep, voffA);
            PG8_WAIT_L(8); PG8_BAR; PG8_WAIT_L(0); PG8_MMA(0, 0, At, B0); PG8_BAR; PG8_SCHED;
            PG8_LDB(B1, 1, 1); PG8_STAGE(PG8_SB(1, 0), b3, voffB);
            PG8_BAR; PG8_WAIT_L(0); PG8_MMA(0, 1, At, B1); PG8_BAR;
            PG8_LDA(At, 1, 1); PG8_STAGE(PG8_SA(1, 0), a3, voffA);
            PG8_BAR; PG8_WAIT_L(0); PG8_MMA(1, 0, At, B0); PG8_BAR; PG8_SCHED;
            PG8_STAGE(PG8_SB(1, 1), b3 + hstep, voffB);
            PG8_WAIT_V(6); PG8_BAR; PG8_MMA(1, 1, At, B1); PG8_BAR;
            }
        }
        if constexpr (ALIGN_EPI) { if (wr == 0) PG8_BAR; }
        if constexpr (!Epi::AFTER_DRAIN) { E(acc, cur, ui, wr, wc, fr, fq); S.done(cur); }
        if (!has_next) break;
        E.init(acc, nxt, ui + 1, wr, wc, fr, fq);
        cur = nxt; cA = nA; cB = nB; ++ui;
        if constexpr (ALIGN_EPI) { if (wr == 1) PG8_BAR; }
    }
    PG8_WAIT_V(0);
    if constexpr (!ALIGN_EPI) { if (wr == 0) PG8_BAR; }
    PG8_BAR;
    if constexpr (Epi::AFTER_DRAIN) { E.fused(acc, cur, wr, wc, fr, fq, lds, wid, lane); S.done(cur); }
#undef PG8_SA
#undef PG8_SB
#undef PG8_STAGE
#undef PG8_LDA
#undef PG8_LDB
#undef PG8_MMA
#undef PG8_WAIT_V
#undef PG8_WAIT_L
#undef PG8_BAR
#undef PG8_SCHED
}
}
#define GAS __attribute__((address_space(1)))
#define LAS __attribute__((address_space(3)))
typedef unsigned short bf16;
typedef unsigned v4u __attribute__((ext_vector_type(4)));
typedef float f32x4 __attribute__((ext_vector_type(4)));
typedef short bf16x8 __attribute__((ext_vector_type(8)));
typedef GAS unsigned gu32;
typedef GAS unsigned long long gu64;
#define RLX_AGENT __ATOMIC_RELAXED, __HIP_MEMORY_SCOPE_AGENT
#define LDS_WAIT() asm volatile("s_waitcnt lgkmcnt(0)" ::: "memory")
#define VM_WAIT() asm volatile("s_waitcnt vmcnt(0)" ::: "memory")
__device__ __forceinline__ unsigned long long rt() { return __builtin_amdgcn_s_memrealtime(); }
__device__ __forceinline__ unsigned f2bf(float f) { unsigned u = __builtin_bit_cast(unsigned, f); return (u + 0x7fffu + ((u >> 16) & 1u)) >> 16; }
__device__ __forceinline__ unsigned pk2(float lo, float hi) { return f2bf(lo) | (f2bf(hi) << 16); }

#define XB_TMO      128
#define XB_XCNT(j)  (256  + 64 * (j))
#define XB_XSUB(j)  (1280 + 64 * (j))
#define XB_XGEN(j)  (2304 + 64 * (j))
#define XB_TOP      3328
#define XB_TOPGEN   3392
#define XCD_BAR_WORDS 3456
#define XB_SPIN_CAP (1u << 18)

__device__ __forceinline__ unsigned xb_ld(unsigned* p)              { return __hip_atomic_load(p, __ATOMIC_RELAXED, __HIP_MEMORY_SCOPE_AGENT); }
__device__ __forceinline__ unsigned xb_add(unsigned* p, unsigned v) { return __hip_atomic_fetch_add(p, v, __ATOMIC_RELAXED, __HIP_MEMORY_SCOPE_AGENT); }
__device__ __forceinline__ unsigned xb_xcc_id() { return (unsigned)__builtin_amdgcn_s_getreg((3 << 11) | 20) & 0xFu; }
#define XB_SPIN(cond, bar) do { unsigned _sp = 0; while (cond) { __builtin_amdgcn_s_sleep(1); \
    if ((++_sp & 255u) == 0u) { if (xb_ld(&(bar)[XB_TMO])) break; if (_sp > XB_SPIN_CAP) { atomicAdd(&(bar)[XB_TMO], 1u); break; } } } } while (0)

struct XcdBarrier {
    unsigned* bar; unsigned x;
    volatile LAS unsigned* st;
};

__device__ __forceinline__ XcdBarrier xcd_barrier_post(unsigned* bar, volatile LAS unsigned* st) {
    XcdBarrier b; b.bar = bar; b.x = xb_xcc_id(); b.st = st;
    if (threadIdx.x == 0) (void)xb_add(&bar[XB_XCNT(b.x)], 1u);
    return b;
}
__device__ __forceinline__ void xcd_barrier_complete(unsigned* bar, unsigned x, unsigned& nloc, unsigned& nx) {
    const unsigned G = gridDim.x * gridDim.y * gridDim.z;
    unsigned sum, cnt, mine, sp = 0u;
    for (;;) {
        sum = 0u; cnt = 0u; mine = 0u;
#pragma unroll
        for (unsigned j = 0; j < 16; ++j) { const unsigned c = xb_ld(&bar[XB_XCNT(j)]); sum += c; cnt += (c > 0u) ? 1u : 0u; mine = (j == x) ? c : mine; }
        if (sum == G) break;
        __builtin_amdgcn_s_sleep(1);
        if ((++sp & 255u) == 0u) { if (xb_ld(&bar[XB_TMO])) break; if (sp > XB_SPIN_CAP) { atomicAdd(&bar[XB_TMO], 1u); break; } }
    }
    nloc = mine > 0u ? mine : 1u; nx = cnt > 0u ? cnt : 1u;
}

__device__ __forceinline__ void xcd_barrier(const XcdBarrier& b) {
    asm volatile("s_waitcnt vmcnt(0)" ::: "memory");
    __syncthreads();
    if (threadIdx.x == 0) {
        unsigned* bar = b.bar;
        __builtin_amdgcn_s_waitcnt(0);
        unsigned nloc = b.st[0], nx = b.st[1];
        if (nloc == 0u) { xcd_barrier_complete(bar, b.x, nloc, nx); b.st[0] = nloc; b.st[1] = nx; }
        const unsigned old = xb_add(&bar[XB_XSUB(b.x)], 1u);
        const unsigned gen = old / nloc;
        if (old + 1u == (gen + 1u) * nloc) {
            __builtin_amdgcn_fence(__ATOMIC_RELEASE, "agent");
            asm volatile("s_waitcnt vmcnt(0)" ::: "memory");
            const unsigned og = xb_add(&bar[XB_TOP], 1u);
            const unsigned tg = og / nx;
            if (og + 1u == (tg + 1u) * nx) xb_add(&bar[XB_TOPGEN], 1u);
            else XB_SPIN(xb_ld(&bar[XB_TOPGEN]) == tg, bar);
            __builtin_amdgcn_fence(__ATOMIC_ACQUIRE, "agent");
            xb_add(&bar[XB_XGEN(b.x)], 1u);
            asm volatile("s_waitcnt vmcnt(0)" ::: "memory");
        } else {
            XB_SPIN(xb_ld(&bar[XB_XGEN(b.x)]) == gen, bar);
            __builtin_amdgcn_fence(__ATOMIC_ACQUIRE, "agent");
            asm volatile("s_waitcnt vmcnt(0)" ::: "memory");
        }
    }
    __syncthreads();
}


struct Frame {
    LAS unsigned char* lds;
    volatile LAS unsigned* MISC;
    gu32* ctl;
    int tid, lane, wave, G;
    const float *x_prompt, *x_sample, *cache_k, *cache_v, *state_conv, *meta, *w_in, *conv_w, *sinks, *w_out, *ln_g, *ln_b;
    float* out;
    bf16 *WtIn, *WtOut, *Yb, *H, *MIX;
    float *Y, *XST, *C1, *C2;
};

__device__ __forceinline__ float bf_lo(unsigned w) { return __uint_as_float(w << 16); }
__device__ __forceinline__ float bf_hi(unsigned w) { return __uint_as_float(w & 0xffff0000u); }
__device__ __forceinline__ float silu_f(float g) { return g * __builtin_amdgcn_rcpf(1.0f + __builtin_amdgcn_exp2f(-1.4426950408889634f * g)); }
__device__ __forceinline__ float wave_sum(float v) {
#pragma unroll
    for (int o = 1; o < 64; o <<= 1) v += __shfl_xor(v, o);
    return v;
}

struct P0Item { const float* W; bf16* WT; const float* gs; const float* bs; float* c1; float* c2; int N, k0, n0; };
constexpr int P0_I_IN = (DMODEL / 64) * (PROJ / 32), P0_I_OUT = (DMODEL / 64) * (DMODEL / 32), P0_NITEMS = DEPTH * (P0_I_IN + P0_I_OUT);
__device__ __forceinline__ P0Item p0_item(const Frame& F, int it) {
    P0Item I; int r = it; const int l = r / (P0_I_IN + P0_I_OUT); r -= l * (P0_I_IN + P0_I_OUT);
    if (r < P0_I_IN) { I.W = F.w_in + (size_t)l * DMODEL * PROJ; I.WT = F.WtIn + (size_t)l * PROJ * DMODEL; I.gs = l > 0 ? F.ln_g + (l - 1) * DMODEL : nullptr; I.bs = l > 0 ? F.ln_b + (l - 1) * DMODEL : nullptr;
        I.c1 = F.C1 + l * PROJ; I.c2 = F.C2 + l * PROJ; I.N = PROJ; }
    else { r -= P0_I_IN; I.W = F.w_out + (size_t)l * DMODEL * DMODEL; I.WT = F.WtOut + (size_t)l * DMODEL * DMODEL; I.gs = nullptr; I.bs = nullptr; I.c1 = nullptr; I.c2 = nullptr; I.N = DMODEL; }
    const int nblk = I.N / 32; I.k0 = 64 * (r / nblk); I.n0 = 32 * (r % nblk); return I;
}
__device__ __forceinline__ void p0_load(const P0Item& I, f32x4 (&v)[8], int lane) {
    const float* p = I.W + (size_t)(I.k0 + (lane >> 3)) * I.N + I.n0 + 4 * (lane & 7);
#pragma unroll
    for (int i = 0; i < 8; ++i) v[i] = *(const GAS f32x4*)(p + (size_t)(8 * i) * I.N);
}
__device__ __forceinline__ void p0_process(const P0Item& I, const f32x4 (&v)[8], LAS float* scr, int lane) {
    const int rr = lane >> 3, c4 = lane & 7;
    f32x4 s1 = (f32x4){0.f, 0.f, 0.f, 0.f}, s2 = s1;
#pragma unroll
    for (int i = 0; i < 8; ++i) { f32x4 w = v[i];
        if (I.gs) { const float g = I.gs[I.k0 + 8 * i + rr], b = I.bs[I.k0 + 8 * i + rr]; s2 += w * b; w = w * g;
            s1 += (f32x4){__uint_as_float(f2bf(w.x) << 16), __uint_as_float(f2bf(w.y) << 16), __uint_as_float(f2bf(w.z) << 16), __uint_as_float(f2bf(w.w) << 16)}; }
        LAS float* d = scr + (8 * i + rr) * 33 + 4 * c4; d[0] = w.x; d[1] = w.y; d[2] = w.z; d[3] = w.w; }
    if (I.gs) {
#pragma unroll
        for (int e = 0; e < 4; ++e) { float a = s1[e], b = s2[e]; a += __shfl_xor(a, 8); b += __shfl_xor(b, 8); a += __shfl_xor(a, 16); b += __shfl_xor(b, 16); a += __shfl_xor(a, 32); b += __shfl_xor(b, 32);
            if (lane < 8) { atomicAdd(I.c1 + I.n0 + 4 * lane + e, a); atomicAdd(I.c2 + I.n0 + 4 * lane + e, b); } } }
    LDS_WAIT(); asm volatile("" ::: "memory");
    const int c = lane & 7;
#pragma unroll
    for (int j = 0; j < 4; ++j) { const int n = (lane >> 3) + 8 * j; const LAS float* s = scr + (8 * c) * 33 + n;
        v4u o; o.x = pk2(s[0 * 33], s[1 * 33]); o.y = pk2(s[2 * 33], s[3 * 33]); o.z = pk2(s[4 * 33], s[5 * 33]); o.w = pk2(s[6 * 33], s[7 * 33]);
        *(GAS v4u*)(I.WT + (size_t)(I.n0 + n) * DMODEL + I.k0 + 8 * c) = o; }
    LDS_WAIT(); asm volatile("" ::: "memory");
}
__device__ __forceinline__ void p0_prologue(Frame& F) {
    LAS float* scr = (LAS float*)(F.lds + F.wave * 16384);
    const int gw = blockIdx.x * NWAVES + F.wave, NGW = F.G * NWAVES, lane = F.lane;
    for (int m = gw; m < MPAD; m += NGW) {
        const float* src = nullptr;
        if (m < MP) { const int b = m / LSEQ, pos = m - b * LSEQ; src = pos < NMETA ? F.meta + (size_t)pos * DMODEL : F.x_prompt + ((size_t)b * SEQ + (pos - NMETA)) * DMODEL; }
        else if (m < MV) src = F.x_sample + (size_t)(m - MP) * DMODEL;
        GAS f32x4* yo = (GAS f32x4*)(F.Y + (size_t)m * DMODEL) + lane; GAS unsigned long long* yb = (GAS unsigned long long*)(F.Yb + (size_t)m * DMODEL) + lane;
        f32x4 v[8];
#pragma unroll
        for (int j = 0; j < 8; ++j) { v[j] = (f32x4){0.f, 0.f, 0.f, 0.f}; if (src) v[j] = ((const GAS f32x4*)src)[lane + 64 * j]; }
#pragma unroll
        for (int j = 0; j < 8; ++j) { yo[64 * j] = v[j]; yb[64 * j] = (unsigned long long)pk2(v[j].x, v[j].y) | ((unsigned long long)pk2(v[j].z, v[j].w) << 32); }
    }
    {
        int it = gw; bool have = it < P0_NITEMS; P0Item ci{}; f32x4 cur[8];
        if (have) { ci = p0_item(F, it); p0_load(ci, cur, lane); }
        while (have) {
            const int itn = it + NGW; const bool hn = itn < P0_NITEMS; P0Item ni{}; f32x4 nxt[8];
            if (hn) { ni = p0_item(F, itn); p0_load(ni, nxt, lane); }
            else {
#pragma unroll
                for (int i = 0; i < 8; ++i) nxt[i] = (f32x4){0.f, 0.f, 0.f, 0.f}; }
            p0_process(ci, cur, scr, lane);
#pragma unroll
            for (int i = 0; i < 8; ++i) cur[i] = nxt[i];
            ci = ni; it = itn; have = hn;
        }
    }
    const int gt = blockIdx.x * (NWAVES * 64) + F.tid, NGT = F.G * NWAVES * 64;
    { constexpr int PER = (WINDOW - DECSEQ) * KVDIM / 4, TOT = 2 * DEPTH * DECB * PER;
      for (int e0 = gt; e0 < TOT; e0 += 4 * NGT) { f32x4 v[4];
#pragma unroll
          for (int q = 0; q < 4; ++q) { const int e = e0 + q * NGT; if (e < TOT) { const int which = e / (DEPTH * DECB * PER), r = e - which * (DEPTH * DECB * PER), ln = r / PER, i = r - ln * PER;
              v[q] = ((const GAS f32x4*)((which ? F.cache_v : F.cache_k) + (size_t)ln * WINDOW * KVDIM + DECSEQ * KVDIM))[i]; } }
#pragma unroll
          for (int q = 0; q < 4; ++q) { const int e = e0 + q * NGT; if (e < TOT) { const int which = e / (DEPTH * DECB * PER), r = e - which * (DEPTH * DECB * PER), ln = r / PER, i = r - ln * PER;
              ((GAS f32x4*)(F.out + (which ? O_VWS : O_KWS) + (size_t)ln * WINDOW * KVDIM))[i] = v[q]; } } } }
    for (int e = gt; e < (MPAD - MV) * DMODEL / 8; e += NGT) ((GAS v4u*)(F.MIX + (size_t)MV * DMODEL))[e] = (v4u){0u, 0u, 0u, 0u};
}

typedef float f32x16 __attribute__((ext_vector_type(16)));
typedef short s16x4 __attribute__((ext_vector_type(4)));
constexpr int TROW = 144;
constexpr int KT_OFF = 0, VT_OFF = 192 * TROW, ST_OFF = 2 * 192 * TROW, ST_WAVE = 32 * TROW;
static_assert(ST_OFF + NWAVES * ST_WAVE <= 131072, "attention LDS");
__device__ __forceinline__ int crow(int r, int hi) { return (r & 3) + 8 * (r >> 2) + 4 * hi; }
__device__ __forceinline__ s16x4 vtr(const LAS unsigned char* p) { return __builtin_bit_cast(s16x4, __builtin_amdgcn_ds_read_tr16_b64_v4i16((LAS s16x4*)p)); }
__device__ __forceinline__ v4u pack8(f32x4 a, f32x4 b) { v4u o; o.x = pg8::cvt_pk_bf16(a.x, a.y); o.y = pg8::cvt_pk_bf16(a.z, a.w); o.z = pg8::cvt_pk_bf16(b.x, b.y); o.w = pg8::cvt_pk_bf16(b.z, b.w); return o; }

constexpr int NQB = (LSEQ + 63) / 64;
constexpr int N_PUNITS = NB * NKV * NQB, N_SUNITS = DECB * NKV, N_UNITS = N_PUNITS + N_SUNITS;

__device__ __forceinline__ void attn_conv_unit(Frame& F, int layer, int u) {
    const int tid = F.tid, lane = F.lane, wave = F.wave;
    const bf16* H = F.H; bf16* MIX = F.MIX;
    LAS unsigned char* Kt = F.lds + KT_OFF; LAS unsigned char* Vt = F.lds + VT_OFF;
    const bool is_prompt = u < N_PUNITS;
    int kvh, q0 = 0, rowbase, bn;
    if (is_prompt) { const int qb = u % NQB; kvh = (u / NQB) % NKV; bn = u / (NQB * NKV); q0 = qb * 64; rowbase = bn * LSEQ; }
    else { const int us = u - N_PUNITS; bn = us / NKV; kvh = us % NKV; rowbase = MP + bn * DECSEQ; }
    const float* cw = F.conv_w + (size_t)layer * 3 * CONVD;
    {
        const int cg = tid & 31, ch0 = kvh * 256 + cg * 8;
        f32x4 w0a = *(const f32x4*)(cw + ch0), w0b = *(const f32x4*)(cw + ch0 + 4), w1a = *(const f32x4*)(cw + CONVD + ch0), w1b = *(const f32x4*)(cw + CONVD + ch0 + 4),
              w2a = *(const f32x4*)(cw + 2 * CONVD + ch0), w2b = *(const f32x4*)(cw + 2 * CONVD + ch0 + 4);
        if (is_prompt) {
            const int p0 = q0 + 4 * (tid >> 5);
            f32x4 ua[6], ub[6];
#pragma unroll
            for (int i = 0; i < 6; ++i) { const int p = p0 - 2 + i; ua[i] = (f32x4){0.f, 0.f, 0.f, 0.f}; ub[i] = ua[i];
                if (p >= 0 && p < LSEQ) { const bf16* hr = H + (size_t)(rowbase + p) * PROJ; const v4u c = *(const GAS v4u*)(hr + H_CG + ch0), h = *(const GAS v4u*)(hr + H_HC + ch0);
                    ua[i] = (f32x4){bf_lo(c.x) * bf_lo(h.x), bf_hi(c.x) * bf_hi(h.x), bf_lo(c.y) * bf_lo(h.y), bf_hi(c.y) * bf_hi(h.y)};
                    ub[i] = (f32x4){bf_lo(c.z) * bf_lo(h.z), bf_hi(c.z) * bf_hi(h.z), bf_lo(c.w) * bf_lo(h.w), bf_hi(c.w) * bf_hi(h.w)}; } }
#pragma unroll
            for (int i = 0; i < 4; ++i) { const int p = p0 + i;
                if (p < LSEQ) { const bf16* hr = H + (size_t)(rowbase + p) * PROJ; const v4u bg = *(const GAS v4u*)(hr + H_BG + ch0), gc = *(const GAS v4u*)(hr + H_GC + ch0);
                    const f32x4 ya = w0a * ua[i] + w1a * ua[i + 1] + w2a * ua[i + 2], yb = w0b * ub[i] + w1b * ub[i + 1] + w2b * ub[i + 2];
                    f32x4 oa, ob;
                    oa.x = bf_lo(bg.x) * ya.x * silu_f(bf_lo(gc.x)); oa.y = bf_hi(bg.x) * ya.y * silu_f(bf_hi(gc.x)); oa.z = bf_lo(bg.y) * ya.z * silu_f(bf_lo(gc.y)); oa.w = bf_hi(bg.y) * ya.w * silu_f(bf_hi(gc.y));
                    ob.x = bf_lo(bg.z) * yb.x * silu_f(bf_lo(gc.z)); ob.y = bf_hi(bg.z) * yb.y * silu_f(bf_hi(gc.z)); ob.z = bf_lo(bg.w) * yb.z * silu_f(bf_lo(gc.w)); ob.w = bf_hi(bg.w) * yb.w * silu_f(bf_hi(gc.w));
                    *(GAS v4u*)(MIX + (size_t)(rowbase + p) * DMODEL + ATT + ch0) = pack8(oa, ob);
                    if (p >= LSEQ - 2) { float* cs = F.out + O_CP + ((size_t)(layer * NB + bn) * 2 + (p - (LSEQ - 2))) * CONVD + ch0; *(GAS f32x4*)cs = ua[i + 2]; *(GAS f32x4*)(cs + 4) = ub[i + 2]; } } }
        } else if (tid < 128) {
            const int t = tid >> 5;
            f32x4 ua[3], ub[3];
#pragma unroll
            for (int i = 0; i < 3; ++i) { const int p = t - 2 + i;
                if (p >= 0) { const bf16* hr = H + (size_t)(rowbase + p) * PROJ; const v4u c = *(const GAS v4u*)(hr + H_CG + ch0), h = *(const GAS v4u*)(hr + H_HC + ch0);
                    ua[i] = (f32x4){bf_lo(c.x) * bf_lo(h.x), bf_hi(c.x) * bf_hi(h.x), bf_lo(c.y) * bf_lo(h.y), bf_hi(c.y) * bf_hi(h.y)};
                    ub[i] = (f32x4){bf_lo(c.z) * bf_lo(h.z), bf_hi(c.z) * bf_hi(h.z), bf_lo(c.w) * bf_lo(h.w), bf_hi(c.w) * bf_hi(h.w)}; }
                else { const float* sr = F.state_conv + ((size_t)(layer * DECB + bn) * 2 + (2 + p)) * CONVD + ch0; ua[i] = *(const GAS f32x4*)sr; ub[i] = *(const GAS f32x4*)(sr + 4); } }
            const bf16* hr = H + (size_t)(rowbase + t) * PROJ; const v4u bg = *(const GAS v4u*)(hr + H_BG + ch0), gc = *(const GAS v4u*)(hr + H_GC + ch0);
            const f32x4 ya = w0a * ua[0] + w1a * ua[1] + w2a * ua[2], yb = w0b * ub[0] + w1b * ub[1] + w2b * ub[2];
            f32x4 oa, ob;
            oa.x = bf_lo(bg.x) * ya.x * silu_f(bf_lo(gc.x)); oa.y = bf_hi(bg.x) * ya.y * silu_f(bf_hi(gc.x)); oa.z = bf_lo(bg.y) * ya.z * silu_f(bf_lo(gc.y)); oa.w = bf_hi(bg.y) * ya.w * silu_f(bf_hi(gc.y));
            ob.x = bf_lo(bg.z) * yb.x * silu_f(bf_lo(gc.z)); ob.y = bf_hi(bg.z) * yb.y * silu_f(bf_hi(gc.z)); ob.z = bf_lo(bg.w) * yb.z * silu_f(bf_lo(gc.w)); ob.w = bf_hi(bg.w) * yb.w * silu_f(bf_hi(gc.w));
            *(GAS v4u*)(MIX + (size_t)(rowbase + t) * DMODEL + ATT + ch0) = pack8(oa, ob);
            if (t >= DECSEQ - 2) { float* cs = F.out + O_CS + ((size_t)(layer * DECB + bn) * 2 + (t - (DECSEQ - 2))) * CONVD + ch0; *(GAS f32x4*)cs = ua[2]; *(GAS f32x4*)(cs + 4) = ub[2]; }
        }
    }
    if (is_prompt) {
#pragma unroll
        for (int i = 0; i < 3; ++i) { const int idx = tid + 512 * i, row = idx >> 3, ch = idx & 7, pos = q0 - 128 + row;
            v4u kv = (v4u){0u, 0u, 0u, 0u}, vv = kv;
            if (pos >= 0) { const bf16* hr = H + (size_t)(rowbase + pos) * PROJ + kvh * 64 + ch * 8; kv = *(const GAS v4u*)(hr + H_K); vv = *(const GAS v4u*)(hr + H_V); }
            *(LAS v4u*)(Kt + row * TROW + ch * 16) = kv; *(LAS v4u*)(Vt + row * TROW + ch * 16) = vv; }
    } else {
#pragma unroll
        for (int i = 0; i < 3; ++i) { const int idx = tid + 512 * i, row = idx >> 3, ch = idx & 7;
            if (idx < 160 * 8) { v4u kv = (v4u){0u, 0u, 0u, 0u}, vv = kv;
                if (row < WINDOW) { const size_t off = (((size_t)(layer * DECB + bn) * WINDOW + row) * NKV + kvh) * 64 + ch * 8;
                    const f32x4 k0 = *(const GAS f32x4*)(F.cache_k + off), k1 = *(const GAS f32x4*)(F.cache_k + off + 4), v0 = *(const GAS f32x4*)(F.cache_v + off), v1 = *(const GAS f32x4*)(F.cache_v + off + 4);
                    kv = pack8(k0, k1); vv = pack8(v0, v1); }
                else if (row < WINDOW + DECSEQ) { const int t = row - WINDOW; const bf16* hr = H + (size_t)(rowbase + t) * PROJ + kvh * 64 + ch * 8; kv = *(const GAS v4u*)(hr + H_K); vv = *(const GAS v4u*)(hr + H_V);
                    const size_t oo = (((size_t)(layer * DECB + bn) * WINDOW + (WINDOW - DECSEQ + t)) * NKV + kvh) * 64 + ch * 8;
                    *(GAS f32x4*)(F.out + O_KWS + oo) = (f32x4){bf_lo(kv.x), bf_hi(kv.x), bf_lo(kv.y), bf_hi(kv.y)}; *(GAS f32x4*)(F.out + O_KWS + oo + 4) = (f32x4){bf_lo(kv.z), bf_hi(kv.z), bf_lo(kv.w), bf_hi(kv.w)};
                    *(GAS f32x4*)(F.out + O_VWS + oo) = (f32x4){bf_lo(vv.x), bf_hi(vv.x), bf_lo(vv.y), bf_hi(vv.y)}; *(GAS f32x4*)(F.out + O_VWS + oo + 4) = (f32x4){bf_lo(vv.z), bf_hi(vv.z), bf_lo(vv.w), bf_hi(vv.w)}; }
                *(LAS v4u*)(Kt + row * TROW + ch * 16) = kv; *(LAS v4u*)(Vt + row * TROW + ch * 16) = vv; } }
    }
    __syncthreads();
    if (is_prompt || wave < 4) {
        int r = lane & 31, h = lane >> 5; asm volatile("" : "+v"(r), "+v"(h));
        const int g = is_prompt ? (wave >> 1) : wave, sub = is_prompt ? 32 * (wave & 1) : 0, hd = kvh * 4 + g;
        const int qrow0 = is_prompt ? rowbase + q0 + sub : rowbase;
        const int qpos0 = is_prompt ? q0 + sub : WINDOW;
        const int nvalid = is_prompt ? min(32, LSEQ - qpos0) : DECSEQ;
        const float slope_l2 = exp2f(-0.5f * (float)(hd + 1)) * 1.4426950408889634f, sink_l2 = F.sinks[layer * NHEADS + hd] * 1.4426950408889634f;
        constexpr float SC = 0.125f * 1.4426950408889634f;
        bf16x8 qf[4];
        { const bf16* qp = H + (size_t)(qrow0 + r) * PROJ + hd * 64 + 8 * h;
#pragma unroll
          for (int d0 = 0; d0 < 4; ++d0) qf[d0] = *(const GAS bf16x8*)(qp + 16 * d0); }
        f32x16 s[5];
#pragma unroll
        for (int j = 0; j < 5; ++j) { s[j] = (f32x16){0.f, 0.f, 0.f, 0.f, 0.f, 0.f, 0.f, 0.f, 0.f, 0.f, 0.f, 0.f, 0.f, 0.f, 0.f, 0.f};
            const LAS unsigned char* kp = Kt + (sub + 32 * j + r) * TROW + 16 * h;
#pragma unroll
            for (int d0 = 0; d0 < 4; ++d0) { const bf16x8 kf = *(const LAS bf16x8*)(kp + 32 * d0); s[j] = __builtin_amdgcn_mfma_f32_32x32x16_bf16(kf, qf[d0], s[j], 0, 0, 0); }
            asm volatile("" ::: "memory"); }
        float mx = sink_l2;
        constexpr unsigned NEGB = 0xF149F2CAu;
#pragma unroll
        for (int j = 0; j < 5; ++j) {
            const int lo = (j == 0) ? max(r + 1, 128 - qpos0) : (128 - 32 * j - qpos0);
            const float dbase = (float)(128 - 32 * j + r);
#pragma unroll
            for (int i = 0; i < 16; ++i) { const int ki = crow(i, h); const int x = (j == 4) ? (r - ki) : (ki - lo);
                const float bias = __uint_as_float((unsigned)(x >> 31) & NEGB);
                const float t = (s[j][i] * SC - slope_l2 * (dbase - (float)ki)) + bias; s[j][i] = t; mx = fmaxf(mx, t); }
            asm volatile("" : "+v"(s[j]), "+v"(mx));
        }
        mx = fmaxf(mx, __shfl_xor(mx, 32));
        float sum = 0.f;
#pragma unroll
        for (int j = 0; j < 5; ++j)
#pragma unroll
            for (int i = 0; i < 16; ++i) { const float p = __builtin_amdgcn_exp2f(s[j][i] - mx); s[j][i] = p; sum += p; }
        sum += __shfl_xor(sum, 32);
        const float inv = 1.0f / (sum + __builtin_amdgcn_exp2f(sink_l2 - mx));
        f32x16 o[2];
        o[0] = (f32x16){0.f, 0.f, 0.f, 0.f, 0.f, 0.f, 0.f, 0.f, 0.f, 0.f, 0.f, 0.f, 0.f, 0.f, 0.f, 0.f}; o[1] = o[0];
        const int q4 = (lane & 15) >> 2, p4 = lane & 3, gb = (lane >> 4) & 1;
        const LAS unsigned char* vp = Vt + (sub + 4 * h + q4) * TROW + (16 * gb + 4 * p4) * 2;
#pragma unroll
        for (int j = 0; j < 5; ++j)
#pragma unroll
            for (int s2 = 0; s2 < 2; ++s2) {
                v4u pw; pw.x = pg8::cvt_pk_bf16(s[j][8 * s2 + 0], s[j][8 * s2 + 1]); pw.y = pg8::cvt_pk_bf16(s[j][8 * s2 + 2], s[j][8 * s2 + 3]);
                pw.z = pg8::cvt_pk_bf16(s[j][8 * s2 + 4], s[j][8 * s2 + 5]); pw.w = pg8::cvt_pk_bf16(s[j][8 * s2 + 6], s[j][8 * s2 + 7]);
                const bf16x8 pf = __builtin_bit_cast(bf16x8, pw);
#pragma unroll
                for (int db = 0; db < 2; ++db) { const LAS unsigned char* a = vp + (32 * j + 16 * s2) * TROW + 64 * db;
                    const s16x4 lo = vtr(a), hi = vtr(a + 8 * TROW);
                    const bf16x8 vf = (bf16x8){lo[0], lo[1], lo[2], lo[3], hi[0], hi[1], hi[2], hi[3]};
                    o[db] = __builtin_amdgcn_mfma_f32_32x32x16_bf16(vf, pf, o[db], 0, 0, 0); }
                asm volatile("" ::: "memory"); }
        LAS unsigned char* st = F.lds + ST_OFF + wave * ST_WAVE;
#pragma unroll
        for (int db = 0; db < 2; ++db)
#pragma unroll
            for (int ig = 0; ig < 4; ++ig) { pg8::u32x2v w; w.x = pg8::cvt_pk_bf16(o[db][4 * ig] * inv, o[db][4 * ig + 1] * inv); w.y = pg8::cvt_pk_bf16(o[db][4 * ig + 2] * inv, o[db][4 * ig + 3] * inv);
                *(LAS pg8::u32x2v*)(st + r * TROW + (32 * db + 8 * ig + 4 * h) * 2) = w; }
        asm volatile("s_waitcnt lgkmcnt(0)" ::: "memory");
#pragma unroll
        for (int it = 0; it < 4; ++it) { const int row = it * 8 + (lane >> 3), ch = lane & 7;
            const v4u ov = *(const LAS v4u*)(st + row * TROW + ch * 16);
            if (row < nvalid) { const v4u gv = *(const GAS v4u*)(H + (size_t)(qrow0 + row) * PROJ + H_GA + hd * 64 + ch * 8);
                f32x4 a, b;
                a.x = bf_lo(ov.x) * silu_f(bf_lo(gv.x)); a.y = bf_hi(ov.x) * silu_f(bf_hi(gv.x)); a.z = bf_lo(ov.y) * silu_f(bf_lo(gv.y)); a.w = bf_hi(ov.y) * silu_f(bf_hi(gv.y));
                b.x = bf_lo(ov.z) * silu_f(bf_lo(gv.z)); b.y = bf_hi(ov.z) * silu_f(bf_hi(gv.z)); b.z = bf_lo(ov.w) * silu_f(bf_lo(gv.w)); b.w = bf_hi(ov.w) * silu_f(bf_hi(gv.w));
                *(GAS v4u*)(MIX + (size_t)(qrow0 + row) * DMODEL + hd * 64 + ch * 8) = pack8(a, b); } }
    }
    __syncthreads();
}
__device__ __forceinline__ void attn_conv_phase(Frame& F0, int layer) {
    Frame F = F0; asm volatile("" : "+v"(F.tid)); F.lane = F.tid & 63;
    for (int u = blockIdx.x; u < N_UNITS; u += F.G) attn_conv_unit(F, layer, u);
    const int gt = blockIdx.x * (NWAVES * 64) + F.tid, NGT = F.G * NWAVES * 64;
    for (int e = gt; e < NB * WINDOW * 2 * KVDIM / 4; e += NGT) { const int b = e / (WINDOW * 2 * KVDIM / 4), r = e - b * (WINDOW * 2 * KVDIM / 4), i = r / (2 * KVDIM / 4), c = (r - i * (2 * KVDIM / 4)) * 4;
        const unsigned long long w = *(const GAS unsigned long long*)(F.H + (size_t)(b * LSEQ + LSEQ - WINDOW + i) * PROJ + H_K + c);
        const unsigned lo = (unsigned)w, hi = (unsigned)(w >> 32);
        float* dst = F.out + (c < KVDIM ? O_KWP : O_VWP) + ((size_t)(layer * NB + b) * WINDOW + i) * KVDIM + (c < KVDIM ? c : c - KVDIM);
        *(GAS f32x4*)dst = (f32x4){bf_lo(lo), bf_hi(lo), bf_lo(hi), bf_hi(hi)}; }
}
__device__ __forceinline__ void final_ln_phase(Frame& F) {
    const int gw = blockIdx.x * NWAVES + F.wave, NGW = F.G * NWAVES, lane = F.lane;
    const float* st = F.XST + (size_t)((DEPTH - 1) & 1) * MPAD * 16; const float* g = F.ln_g + (DEPTH - 1) * DMODEL; const float* b = F.ln_b + (DEPTH - 1) * DMODEL;
    for (int m = gw; m < MV; m += NGW) {
        float* dst;
        if (m < MP) { const int bb = m / LSEQ, pos = m - bb * LSEQ; if (pos < NMETA) continue; dst = F.out + O_YP + ((size_t)bb * SEQ + (pos - NMETA)) * DMODEL; }
        else dst = F.out + O_YS + (size_t)(m - MP) * DMODEL;
        float mu, rs; pg8::row_stats(st + (size_t)m * 16, mu, rs);
        const GAS f32x4* yr = (const GAS f32x4*)(F.Y + (size_t)m * DMODEL) + lane;
#pragma unroll
        for (int j = 0; j < 8; ++j) { const f32x4 v = yr[64 * j], gg = ((const GAS f32x4*)g)[lane + 64 * j], bb2 = ((const GAS f32x4*)b)[lane + 64 * j];
            ((GAS f32x4*)dst)[lane + 64 * j] = (v - mu) * rs * gg + bb2; }
    }
}

struct Args { const float* in[12]; float* out; unsigned char* ws; int ph_lo, ph_hi, li, pad; };
__global__ void __launch_bounds__(NWAVES * 64, 2) hymba_fwd(Args args) {
    extern __shared__ __attribute__((aligned(16))) unsigned char lds[];
    Frame F;
    F.lds = (LAS unsigned char*)lds;
    F.MISC = (volatile LAS unsigned*)(F.lds + MISC_OFF);
    F.tid = threadIdx.x; F.lane = F.tid & 63; F.wave = __builtin_amdgcn_readfirstlane(F.tid >> 6); F.G = gridDim.x;
    unsigned char* ws = args.ws;
    F.ctl = (gu32*)(ws + WS_CTL);
    F.x_prompt = args.in[0]; F.x_sample = args.in[1]; F.cache_k = args.in[2]; F.cache_v = args.in[3]; F.state_conv = args.in[4]; F.meta = args.in[5];
    F.w_in = args.in[6]; F.conv_w = args.in[7]; F.sinks = args.in[8]; F.w_out = args.in[9]; F.ln_g = args.in[10]; F.ln_b = args.in[11]; F.out = args.out;
    F.WtIn = (bf16*)(ws + WS_WTIN); F.WtOut = (bf16*)(ws + WS_WTOUT); F.Yb = (bf16*)(ws + WS_YB); F.H = (bf16*)(ws + WS_H); F.MIX = (bf16*)(ws + WS_MIX);
    F.Y = (float*)(ws + WS_Y); F.XST = (float*)(ws + WS_XST); F.C1 = (float*)(ws + WS_C1); F.C2 = (float*)(ws + WS_C2);
    for (int u = F.tid; u < (LDS_BYTES - LDSCTL_OFF) / 4; u += NWAVES * 64) ((LAS unsigned*)(F.lds + LDSCTL_OFF))[u] = 0u;
    __syncthreads();
    const bool one_launch = (args.ph_hi - args.ph_lo) > 1;
    XcdBarrier bar; bar.bar = (unsigned*)(F.ctl + CW_BAR); bar.x = 0; bar.st = nullptr;
    if (one_launch) bar = xcd_barrier_post((unsigned*)(F.ctl + CW_BAR), F.MISC + 8);
    const int lo = args.ph_lo, hi = args.ph_hi;
#define IN(k) (lo <= (k) && (k) < hi)
#define SEAM(k) do { if (IN(k) && IN((k) + 1)) xcd_barrier(bar); } while (0)
    #ifndef NO_P0
    if (IN(0)) { p0_prologue(F);
#if PROBE_DUP_P0
        xcd_barrier(bar); { Frame F2 = F; F2.C1 = (float*)(ws + WS_END); F2.C2 = (float*)(ws + WS_END + 256 * 1024); p0_prologue(F2); }
#endif
    }
#endif
    SEAM(0);
    for (int l = 0; l < DEPTH; ++l) {
        const int pa = 1 + 3 * l;
#ifndef NO_GEMMA
        if (IN(pa)) {
            pg8::Gemm g{F.Yb, F.WtIn + (size_t)l * PROJ * DMODEL, MPAD, PROJ, DMODEL}; pg8::StaticOrder S; S.init(MPAD, PROJ, F.G, (int)blockIdx.x);
            const pg8::f32x2v LAS* tab = (const pg8::f32x2v LAS*)(F.lds + TAB_OFF);
            pg8::fill_stats_table((pg8::f32x2v LAS*)(F.lds + TAB_OFF), S, F.XST + (size_t)((l + 1) & 1) * MPAD * 16, l > 0 ? 1 : 0, F.tid);
            pg8::EpiH E{F.H, PROJ, F.C1 + l * PROJ, F.C2 + l * PROJ, l > 0 ? 1 : 0, tab};
            pg8::gemm_phase<pg8::EpiH, pg8::StaticOrder, true, true>(F.lds, g, S, E);
#if PROBE_DUP_INPROJ
            xcd_barrier(bar); pg8::gemm_phase<pg8::EpiH, pg8::StaticOrder, true, true>(F.lds, g, S, E);
#endif
        }
#endif
        SEAM(pa);
#ifndef NO_ATTN
        if (IN(pa + 1)) { attn_conv_phase(F, l);
#if PROBE_DUP_ATTN
            xcd_barrier(bar); attn_conv_phase(F, l);
#endif
        }
#endif
        SEAM(pa + 1);
#ifndef NO_GEMMC
        if (IN(pa + 2)) {
            pg8::Gemm g{F.MIX, F.WtOut + (size_t)l * DMODEL * DMODEL, MPAD, DMODEL, DMODEL}; pg8::StaticOrder S; S.init(MPAD, DMODEL, F.G, (int)blockIdx.x);
            const pg8::f32x2v LAS* tab = (const pg8::f32x2v LAS*)(F.lds + TAB_OFF);
            pg8::fill_stats_table((pg8::f32x2v LAS*)(F.lds + TAB_OFF), S, F.XST + (size_t)((l + 1) & 1) * MPAD * 16, l > 0 ? 1 : 0, F.tid);
            pg8::EpiY E{F.Y, F.Yb, F.XST + (size_t)(l & 1) * MPAD * 16, F.ln_g + (l > 0 ? l - 1 : 0) * DMODEL, F.ln_b + (l > 0 ? l - 1 : 0) * DMODEL, l > 0 ? 1 : 0, ALPHA, F.lds + XLDS_OFF, F.Y, tab};
#if PROBE_DUP_OUTPROJ
            { pg8::EpiY E2 = E; E2.Yb = (pg8::bf16_t*)(ws + WS_END + 128 * MiB); E2.stats_out = (float*)(ws + WS_END + 2 * MiB); E2.Y = (float*)(ws + WS_END + 8 * MiB);
              pg8::gemm_phase<pg8::EpiY, pg8::StaticOrder, true, true>(F.lds, g, S, E2); xcd_barrier(bar); }
#endif
            pg8::gemm_phase<pg8::EpiY, pg8::StaticOrder, true, true>(F.lds, g, S, E);
        }
#endif
        SEAM(pa + 2);
    }
#ifndef NO_FIN
    if (IN(1 + 3 * DEPTH)) final_ln_phase(F);
#endif
#undef IN
#undef SEAM
}

extern "C" void kernel_launch(void* const* d_in, const int* in_sizes, int n_in, void* d_out, int out_size, void* d_ws, size_t ws_size, hipStream_t stream) {
    static int grid = 0;
    if (grid == 0) {
        if (n_in != 12 || out_size != O_TOTAL || ws_size < WS_END) { fprintf(stderr, "kernel_launch: unexpected shapes (n_in %d, out %d, ws %zu)\n", n_in, out_size, ws_size); grid = -1; return; }
        int dev = 0, cus = 0, per_cu = 0;
        if (hipGetDevice(&dev) != hipSuccess || hipDeviceGetAttribute(&cus, hipDeviceAttributeMultiprocessorCount, dev) != hipSuccess) { grid = -1; return; }
        if (hipFuncSetAttribute((const void*)hymba_fwd, hipFuncAttributeMaxDynamicSharedMemorySize, LDS_BYTES) != hipSuccess) { fprintf(stderr, "kernel_launch: hipFuncSetAttribute failed\n"); grid = -1; return; }
        if (hipOccupancyMaxActiveBlocksPerMultiprocessor(&per_cu, (const void*)hymba_fwd, NWAVES * 64, LDS_BYTES) != hipSuccess || per_cu < 1) { fprintf(stderr, "kernel_launch: occupancy query says %d blocks per CU\n", per_cu); (void)hipGetLastError(); grid = -1; return; }
        grid = cus;
    }
    if (grid < 0) return;
    (void)hipMemsetAsync((char*)d_ws + WS_CTL, 0, CTL_ZERO_BYTES, stream);
    Args a{};
    for (int i = 0; i < 12; ++i) a.in[i] = (const float*)d_in[i];
    a.out = (float*)d_out; a.ws = (unsigned char*)d_ws;
    constexpr int NPH = 2 + 3 * DEPTH;
#if N_LAUNCHES == 1
    a.ph_lo = 0; a.ph_hi = NPH; a.li = 0;
    hipLaunchKernelGGL(hymba_fwd, dim3(grid), dim3(NWAVES * 64), LDS_BYTES, stream, a);
#else
    for (int p = 0; p < NPH; ++p) { a.ph_lo = p; a.ph_hi = p + 1; a.li = p; hipLaunchKernelGGL(hymba_fwd, dim3(grid), dim3(NWAVES * 64), LDS_BYTES, stream, a); }
#endif
}
```
